# Optimizing an MI355X kernel written in HIP

```python
import math
import jax, jax.numpy as jnp
from jax import lax
import numpy as np

D_MODEL = 1024
BATCH = 8
SEQ = 2048
DEPTH = 1
DEC_BATCH = 32
DEC_SEQ = 64
PAST_LEN = 2048

CHUNK = 64
H_RET = 4
DK_HEAD = D_MODEL // H_RET
DV_HEAD = 2 * DK_HEAD
D_QK = H_RET * DK_HEAD
D_V = H_RET * DV_HEAD
D_CONV = D_MODEL
CONV_WIDTH = 3
D_FF = int(math.ceil(8 * D_MODEL / 3 / 256) * 256)
ROPE_BASE = 10000.0
LN_EPS = 1e-5
RMS_EPS = 1e-6
DEEPNORM_ALPHA = (2.0 * DEPTH) ** 0.25
DEEPNORM_BETA = (8.0 * DEPTH) ** -0.25
SPLIT_WIDTHS = (D_QK, D_QK, D_V, D_V, D_CONV, D_CONV, D_CONV, D_MODEL, D_MODEL)
SPLIT_IDX = tuple(int(v) for v in np.cumsum(SPLIT_WIDTHS)[:-1])
D_IN = int(sum(SPLIT_WIDTHS))

kernel_name = "hybrid_retention_shortconv_deepnorm_step"


def layer_norm(x, g, b):
    xf = x.astype(jnp.float32)
    mu = jnp.mean(xf, axis=-1, keepdims=True)
    xc = xf - mu
    var = jnp.mean(xc * xc, axis=-1, keepdims=True)
    return (xc * lax.rsqrt(var + LN_EPS) * g.astype(jnp.float32) + b.astype(jnp.float32)).astype(x.dtype)


def rotary(t, pos):
    half = DK_HEAD // 2
    inv = 1.0 / (ROPE_BASE ** jnp.linspace(0.0, 1.0, half, dtype=jnp.float32))
    ang = pos.astype(jnp.float32)[:, None] * inv[None, :]
    cos = jnp.cos(ang)[None, :, None, :]
    sin = jnp.sin(ang)[None, :, None, :]
    t1, t2 = t[..., :half], t[..., half:]
    return jnp.concatenate([t1 * cos - t2 * sin, t1 * sin + t2 * cos], axis=-1)


def retention(q, k, v, S0, chunk_len):
    B, L = q.shape[0], q.shape[1]
    n_chunks = L // chunk_len
    log_g = jnp.log(1.0 - 2.0 ** (-5.0 - jnp.arange(H_RET, dtype=jnp.float32)))
    idx = jnp.arange(chunk_len, dtype=jnp.float32)
    dist = jnp.abs(idx[:, None] - idx[None, :])
    intra_dec = jnp.exp(dist[None] * log_g[:, None, None])
    inter_dec = jnp.exp((idx[None, :] + 1.0) * log_g[:, None]).T
    upd_dec = jnp.exp((chunk_len - 1.0 - idx)[None, :] * log_g[:, None]).T
    carry_dec = jnp.exp(chunk_len * log_g)

    def to_chunks(t):
        return jnp.moveaxis(t.reshape((B, n_chunks, chunk_len) + t.shape[2:]), 1, 0)

    def step(S, qkv):
        qc, kc, vc = qkv
        s = jnp.einsum('bihd,bjhd->bhij', qc, kc) * intra_dec[None]
        o = jnp.einsum('bhij,bjhe->bihe', s, vc)
        o = o + jnp.einsum('bihd,bhde->bihe', qc, S) * inter_dec[None, :, :, None]
        S = S * carry_dec[None, :, None, None] + jnp.einsum(
            'bjhd,bjhe->bhde', kc * upd_dec[None, :, :, None], vc)
        return S, o

    S, o = lax.scan(step, S0, (to_chunks(q), to_chunks(k), to_chunks(v)))
    o = jnp.moveaxis(o, 0, 1).reshape(B, L, H_RET, DV_HEAD)
    return o, S


def hybrid_layer(x, pos, S0, buf0, chunk_len, w_in, w_conv, w_ret_out, w_conv_out, w_o,
                 ln1_g, ln1_b, w_up, w_down, ln2_g, ln2_b):
    B, L, _ = x.shape
    proj = x @ w_in
    q, k, v, g, cb, cc, cx, gr, gc = jnp.split(proj, SPLIT_IDX, axis=-1)
    q = rotary(q.reshape(B, L, H_RET, DK_HEAD).astype(jnp.float32), pos)
    k = rotary(k.reshape(B, L, H_RET, DK_HEAD).astype(jnp.float32), pos) * (DK_HEAD ** -0.5)
    v = v.reshape(B, L, H_RET, DV_HEAD).astype(jnp.float32)
    o, S = retention(q, k, v, S0.astype(jnp.float32), chunk_len)
    o = o * lax.rsqrt(jnp.mean(o * o, axis=-1, keepdims=True) + RMS_EPS)
    o = o.reshape(B, L, D_V)
    r = (jax.nn.silu(g.astype(jnp.float32)) * o).astype(x.dtype) @ w_ret_out
    u = cc * cx
    padded = jnp.concatenate([buf0.astype(u.dtype), u], axis=1)
    conv = (w_conv[0] * padded[:, 0:L] + w_conv[1] * padded[:, 1:L + 1]
            + w_conv[2] * padded[:, 2:L + 2])
    c = (cb * conv) @ w_conv_out
    m = jax.nn.sigmoid(gr) * r + jax.nn.sigmoid(gc) * c
    h = layer_norm(DEEPNORM_ALPHA * x + m @ w_o, ln1_g, ln1_b)
    a, b = jnp.split(h @ w_up, 2, axis=-1)
    y = layer_norm(DEEPNORM_ALPHA * h + (jax.nn.silu(a) * b) @ w_down, ln2_g, ln2_b)
    return y, S, padded[:, L:]


def setup_inputs(seed: int = 0) -> dict:
    key = jax.random.key(seed)
    ks = jax.random.split(key, 16)
    f32 = jnp.float32
    nrm = lambda k, shape: jax.random.normal(k, shape, f32)
    return {
        "x_prompt": nrm(ks[0], (BATCH, SEQ, D_MODEL)),
        "x_sample": nrm(ks[1], (DEC_BATCH, DEC_SEQ, D_MODEL)),
        "state_ret": 0.1 * nrm(ks[2], (DEPTH, DEC_BATCH, H_RET, DK_HEAD, DV_HEAD)),
        "cache_conv": nrm(ks[3], (DEPTH, DEC_BATCH, CONV_WIDTH - 1, D_CONV)),
        "w_in": nrm(ks[4], (DEPTH, D_MODEL, D_IN)) * D_MODEL ** -0.5,
        "w_conv": nrm(ks[5], (DEPTH, CONV_WIDTH, D_CONV)) * CONV_WIDTH ** -0.5,
        "w_ret_out": nrm(ks[6], (DEPTH, D_V, D_MODEL)) * (DEEPNORM_BETA * D_V ** -0.5),
        "w_conv_out": nrm(ks[7], (DEPTH, D_CONV, D_MODEL)) * (DEEPNORM_BETA * D_CONV ** -0.5),
        "w_o": nrm(ks[8], (DEPTH, D_MODEL, D_MODEL)) * (DEEPNORM_BETA * D_MODEL ** -0.5),
        "ln1_g": 1.0 + 0.02 * nrm(ks[9], (DEPTH, D_MODEL)),
        "ln1_b": 0.02 * nrm(ks[10], (DEPTH, D_MODEL)),
        "w_up": nrm(ks[11], (DEPTH, D_MODEL, 2 * D_FF)) * (DEEPNORM_BETA * D_MODEL ** -0.5),
        "w_down": nrm(ks[12], (DEPTH, D_FF, D_MODEL)) * (DEEPNORM_BETA * D_FF ** -0.5),
        "ln2_g": 1.0 + 0.02 * nrm(ks[13], (DEPTH, D_MODEL)),
        "ln2_b": 0.02 * nrm(ks[14], (DEPTH, D_MODEL)),
    }


def reference(x_prompt, x_sample, state_ret, cache_conv, w_in, w_conv, w_ret_out, w_conv_out,
              w_o, ln1_g, ln1_b, w_up, w_down, ln2_g, ln2_b):
    bp, lp = x_prompt.shape[0], x_prompt.shape[1]
    ls = x_sample.shape[1]
    pos_p = jnp.arange(lp, dtype=jnp.int32)
    pos_s = PAST_LEN + jnp.arange(ls, dtype=jnp.int32)
    S_zero = jnp.zeros((bp, H_RET, DK_HEAD, DV_HEAD), jnp.float32)
    buf_zero = jnp.zeros((bp, CONV_WIDTH - 1, D_CONV), x_prompt.dtype)
    xp, xs = x_prompt, x_sample
    sp_list, bp_list, ss_list, bs_list = [], [], [], []
    for l in range(DEPTH):
        params = (w_in[l], w_conv[l], w_ret_out[l], w_conv_out[l], w_o[l],
                  ln1_g[l], ln1_b[l], w_up[l], w_down[l], ln2_g[l], ln2_b[l])
        xp, sp, bufp = hybrid_layer(xp, pos_p, S_zero, buf_zero, CHUNK, *params)
        xs, ss, bufs = hybrid_layer(xs, pos_s, state_ret[l], cache_conv[l], ls, *params)
        sp_list.append(sp.astype(state_ret.dtype))
        bp_list.append(bufp.astype(cache_conv.dtype))
        ss_list.append(ss.astype(state_ret.dtype))
        bs_list.append(bufs.astype(cache_conv.dtype))
    return (xp, xs, jnp.stack(sp_list), jnp.stack(bp_list), jnp.stack(ss_list), jnp.stack(bs_list))
```

```cpp
#include <hip/hip_runtime.h>
#include <hip/hip_cooperative_groups.h>
#include <cstdio>
namespace cg = cooperative_groups;
#ifndef MK_LAUNCHES
#define MK_LAUNCHES 11
#endif
namespace pg8 {
#define PG8_LAS __attribute__((address_space(3)))
typedef unsigned short bf16_t;
typedef short bf16x8 __attribute__((ext_vector_type(8)));
typedef float f32x4 __attribute__((ext_vector_type(4)));
typedef unsigned u32x4 __attribute__((ext_vector_type(4)));
constexpr int BM = 256, BK = 64, HALF = 128, HTB = HALF * BK * 2  , STAGE_BYTES = 8 * HTB, NXCD = 8, WGM = 8;

__host__ __device__ __forceinline__ int lds_byte(int r, int c) { const int st = (r >> 4) * 2 + (c >> 5), rr = r & 15, cc = c & 31, ob = rr * 64 + cc * 2; return st * 1024 + (ob ^ (((ob >> 9) & 1) << 5)); }
__host__ __device__ __forceinline__ void stage_rc(int b, int& R, int& C) { const int st = b / 1024, sb = b % 1024, swz = sb ^ (((sb >> 9) & 1) << 5); R = (st >> 1) * 16 + swz / 64; C = (st & 1) * 32 + (swz % 64) / 2; }
__host__ __device__ __forceinline__ int perm32(int rho) { const int n = rho >> 4, i = rho & 15; return 8 * (i >> 2) + 4 * n + (i & 3); }

struct Unit { int pm, pn; };
struct Gemm { const bf16_t* A; const bf16_t* Bt; int M, N, K; };

struct StaticOrder {
    int nM, nN, nwg, G, c;
    __host__ __device__ void init(int M, int N, int G_, int c_) { nM = M / BM; nN = N / BM; nwg = nM * nN; G = G_; c = c_; }
    __host__ __device__ bool next(int i, Unit& u) const {
        const long L = (long)i * G + c; if (L >= nwg) return false;
        int wgid = (int)L; { const int q = nwg / NXCD, r = nwg % NXCD, xcd = wgid % NXCD, off = wgid / NXCD; wgid = (xcd < r ? xcd * (q + 1) : r * (q + 1) + (xcd - r) * q) + off; }
        const int nig = WGM * nN, gid = wgid / nig, fm = gid * WGM, gsz = (nM - fm) < WGM ? (nM - fm) : WGM;
        u.pm = fm + ((wgid % nig) % gsz); u.pn = (wgid % nig) / gsz; return true;
    }
    __device__ __forceinline__ void a_ready(const Unit&) const {}
    __device__ __forceinline__ void done(const Unit&) const {}
};
__device__ __forceinline__ unsigned cvt_pk_bf16(float lo, float hi) { unsigned r; asm volatile("v_cvt_pk_bf16_f32 %0, %1, %2" : "=v"(r) : "v"(lo), "v"(hi)); return r; }
template <class Epi, class Sched, bool STAMP = false>
__device__ __forceinline__ void gemm_phase(PG8_LAS unsigned char* lds, const Gemm g, const Sched& S, const Epi& E, unsigned long long* stamps) {
    const int tid = threadIdx.x, wid = __builtin_amdgcn_readfirstlane(tid >> 6), lane = tid & 63, wr = wid >> 2, wc = wid & 3, fr = lane & 15, fq = lane >> 4;
    const int K = g.K, nt = K / BK;
    int ts_lo = 0, ts_hi = 0, nts = 0; const unsigned long long rt_entry = STAMP ? (unsigned long long)wall_clock64() : 0ull;
#define PG8_STAMP() do { if (STAMP && wid == 0 && nts < 64) { const unsigned long long _c = (unsigned long long)clock64(); \
        ts_lo = (lane == nts) ? (int)(unsigned)_c : ts_lo; ts_hi = (lane == nts) ? (int)(unsigned)(_c >> 32) : ts_hi; ++nts; } } while (0)
    PG8_STAMP();
    unsigned voffA[2], voffB[2];
#pragma unroll
    for (int i = 0; i < 2; ++i) { int R, C; stage_rc(tid * 16 + i * 8192, R, C); const int Rb = Epi::PERM ? ((R & ~31) + perm32(R & 31)) : R;
        voffA[i] = (unsigned)(R * K + C) * 2u; voffB[i] = (unsigned)(Rb * K + C) * 2u; }
    const size_t kstep = (size_t)(BK * 2);
    const size_t hstep = (size_t)HALF * K * 2;
    const size_t tstep = 2 * hstep;
    const unsigned ldsw = (unsigned)wid * 1024u;
    const int aoff = lds_byte(wr * 64 + fr, fq * 8), boff = lds_byte(wc * 32 + fr, fq * 8);
#define PG8_SA(b, h) (((b) * 2 + (h)) * HTB)
#define PG8_SB(b, h) ((4 + (b) * 2 + (h)) * HTB)
#define PG8_STAGE(bufoff, gbase, voff) do { _Pragma("unroll") for (int _i = 0; _i < 2; ++_i) \
        __builtin_amdgcn_global_load_lds((const unsigned*)((const char*)(gbase) + (voff)[_i]), (PG8_LAS unsigned*)(lds + (bufoff) + ldsw + _i * 8192), 16, 0, 0); } while (0)
#define PG8_LDA(dst, b, h) do { _Pragma("unroll") for (int m = 0; m < 4; ++m) _Pragma("unroll") for (int k = 0; k < 2; ++k) dst[m][k] = *(const PG8_LAS bf16x8*)(lds + PG8_SA(b, h) + aoff + m * 2048 + k * 1024); } while (0)
#define PG8_LDB(dst, b, h) do { _Pragma("unroll") for (int n = 0; n < 2; ++n) _Pragma("unroll") for (int k = 0; k < 2; ++k) dst[n][k] = *(const PG8_LAS bf16x8*)(lds + PG8_SB(b, h) + boff + n * 2048 + k * 1024); } while (0)
#define PG8_MMA(ai, bj, At, Bt) do { __builtin_amdgcn_s_setprio(1); _Pragma("unroll") for (int m = 0; m < 4; ++m) _Pragma("unroll") for (int n = 0; n < 2; ++n) _Pragma("unroll") for (int k = 0; k < 2; ++k) \
        acc[ai][bj][m][n] = __builtin_amdgcn_mfma_f32_16x16x32_bf16(Bt[n][k], At[m][k], acc[ai][bj][m][n], 0, 0, 0); __builtin_amdgcn_s_setprio(0); } while (0)
#define PG8_WAIT_V(n) asm volatile("s_waitcnt vmcnt(" #n ")" ::: "memory")
#define PG8_WAIT_L(n) asm volatile("s_waitcnt lgkmcnt(" #n ")" ::: "memory")
#define PG8_BAR __builtin_amdgcn_s_barrier()
#define PG8_SCHED __builtin_amdgcn_sched_barrier(0)
    Unit cur, nxt; int ui = 0;
    if (!S.next(0, cur)) return;
    f32x4 acc[2][2][4][2];
#pragma unroll
    for (int a = 0; a < 2; ++a)
#pragma unroll
        for (int b = 0; b < 2; ++b)
#pragma unroll
            for (int m = 0; m < 4; ++m)
#pragma unroll
                for (int n = 0; n < 2; ++n) acc[a][b][m][n] = (f32x4){0.f, 0.f, 0.f, 0.f};
    bf16x8 At[4][2], B0[2][2], B1[2][2];
    const char* cA = (const char*)g.A + (size_t)cur.pm * tstep; const char* cB = (const char*)g.Bt + (size_t)cur.pn * tstep;
    S.a_ready(cur);
    PG8_STAGE(PG8_SB(0, 0), cB, voffB); PG8_STAGE(PG8_SA(0, 0), cA, voffA); PG8_STAGE(PG8_SB(0, 1), cB + hstep, voffB); PG8_STAGE(PG8_SA(0, 1), cA + hstep, voffA);
    if (wr == 1) PG8_BAR;
    PG8_WAIT_V(4); PG8_BAR;
    PG8_STAGE(PG8_SB(1, 0), cB + kstep, voffB); PG8_STAGE(PG8_SA(1, 0), cA + kstep, voffA); PG8_STAGE(PG8_SB(1, 1), cB + hstep + kstep, voffB);
    PG8_WAIT_V(6); PG8_BAR;
    PG8_STAMP();
    for (;;) {
        const bool has_next = S.next(ui + 1, nxt);
        const char* nA = has_next ? (const char*)g.A + (size_t)nxt.pm * tstep : cA; const char* nB = has_next ? (const char*)g.Bt + (size_t)nxt.pn * tstep : cB;
        for (int t = 0; t < nt; t += 2) {
            const bool last = (t == nt - 2);
            const char* a1 = cA + (size_t)(t + 1) * kstep;
            const char* a2 = last ? nA : cA + (size_t)(t + 2) * kstep; const char* b2 = last ? nB : cB + (size_t)(t + 2) * kstep;
            const char* a3 = a2 + kstep; const char* b3 = b2 + kstep;
            if (last && has_next) S.a_ready(nxt);
            PG8_LDB(B0, 0, 0); PG8_SCHED; PG8_LDA(At, 0, 0); PG8_STAGE(PG8_SA(1, 1), a1 + hstep, voffA);
            PG8_WAIT_L(8); PG8_BAR; PG8_WAIT_L(0); PG8_MMA(0, 0, At, B0); PG8_BAR; PG8_SCHED;
            PG8_LDB(B1, 0, 1); PG8_STAGE(PG8_SB(0, 0), b2, voffB);
            PG8_BAR; PG8_WAIT_L(0); PG8_MMA(0, 1, At, B1); PG8_BAR;
            PG8_LDA(At, 0, 1); PG8_STAGE(PG8_SA(0, 0), a2, voffA);
            PG8_BAR; PG8_WAIT_L(0); PG8_MMA(1, 0, At, B0); PG8_BAR; PG8_SCHED;
            PG8_STAGE(PG8_SB(0, 1), b2 + hstep, voffB);
            PG8_WAIT_V(6); PG8_BAR; PG8_MMA(1, 1, At, B1); PG8_BAR;
            PG8_LDB(B0, 1, 0); PG8_SCHED; PG8_LDA(At, 1, 0); PG8_STAGE(PG8_SA(0, 1), a2 + hstep, voffA);
            PG8_WAIT_L(8); PG8_BAR; PG8_WAIT_L(0); PG8_MMA(0, 0, At, B0); PG8_BAR; PG8_SCHED;
            PG8_LDB(B1, 1, 1); PG8_STAGE(PG8_SB(1, 0), b3, voffB);
            PG8_BAR; PG8_WAIT_L(0); PG8_MMA(0, 1, At, B1); PG8_BAR;
            PG8_LDA(At, 1, 1); PG8_STAGE(PG8_SA(1, 0), a3, voffA);
            PG8_BAR; PG8_WAIT_L(0); PG8_MMA(1, 0, At, B0); PG8_BAR; PG8_SCHED;
            PG8_STAGE(PG8_SB(1, 1), b3 + hstep, voffB);
            PG8_WAIT_V(6); PG8_BAR; PG8_MMA(1, 1, At, B1); PG8_BAR;
        }
        PG8_STAMP();
        if constexpr (!Epi::AFTER_DRAIN) { E(acc, cur, wr, wc, fr, fq); S.done(cur); }
        PG8_STAMP();
        if (!has_next) break;
#pragma unroll
        for (int a = 0; a < 2; ++a)
#pragma unroll
            for (int b = 0; b < 2; ++b)
#pragma unroll
                for (int m = 0; m < 4; ++m)
#pragma unroll
                    for (int n = 0; n < 2; ++n) acc[a][b][m][n] = (f32x4){0.f, 0.f, 0.f, 0.f};
        cur = nxt; cA = nA; cB = nB; ++ui;
    }
    PG8_WAIT_V(0);
    if (wr == 0) PG8_BAR;
    PG8_BAR;
    if constexpr (Epi::AFTER_DRAIN) { E.fused(acc, cur, wr, wc, fr, fq, lds, wid, lane); S.done(cur); }
    PG8_STAMP();
    if (STAMP && wid == 0) { stamps[lane] = lane < nts ? (((unsigned long long)(unsigned)ts_hi << 32) | (unsigned)ts_lo) : 0ull;
        if (lane == 62) stamps[62] = rt_entry; if (lane == 63) stamps[63] = (unsigned long long)wall_clock64(); }
#undef PG8_STAMP
#undef PG8_SA
#undef PG8_SB
#undef PG8_STAGE
#undef PG8_LDA
#undef PG8_LDB
#undef PG8_MMA
#undef PG8_WAIT_V
#undef PG8_WAIT_L
#undef PG8_BAR
#undef PG8_SCHED
}
}
using namespace pg8;
typedef short s16x4 __attribute__((ext_vector_type(4)));
typedef unsigned u32x2 __attribute__((ext_vector_type(2)));
#define LAS PG8_LAS

constexpr int NTOK = 18432, NP = 16384, DM = 1024, DV = 2048, DFF = 2816;
constexpr float ALPHA = 1.189207115002721f;
constexpr size_t WS_XB = 0;
constexpr size_t WS_WIN = WS_XB + (size_t)NTOK * DM * 2;
constexpr size_t WS_WR = WS_WIN + (size_t)11264 * 1024 * 2;
constexpr size_t WS_WC = WS_WR + (size_t)1024 * 2048 * 2;
constexpr size_t WS_WO = WS_WC + (size_t)1024 * 1024 * 2;
constexpr size_t WS_WUP = WS_WO + (size_t)1024 * 1024 * 2;
constexpr size_t WS_WD = WS_WUP + (size_t)5632 * 1024 * 2;
constexpr size_t WS_ROPE = WS_WD + (size_t)1024 * 2816 * 2;
constexpr size_t WS_SSQ = WS_ROPE + (size_t)2112 * 256 * 4;
constexpr size_t WS_Q = WS_SSQ + (size_t)NTOK * 64 * 4;
constexpr size_t WS_K = WS_Q + (size_t)NTOK * DM * 2;
constexpr size_t WS_V = WS_K + (size_t)NTOK * DM * 2;
constexpr size_t WS_END = WS_V + (size_t)NTOK * DV * 2;
constexpr size_t OUT_SP = 18874368, OUT_CP = 23068672, OUT_SS = 23085056, OUT_CS = 39862272;

struct Params {
    const float *x_prompt, *x_sample, *state_ret, *cache_conv, *w_in, *w_conv, *w_ret_out, *w_conv_out, *w_o, *ln1_g, *ln1_b, *w_up, *w_down, *ln2_g, *ln2_b;
    float* out; unsigned char* ws; int ph_lo, ph_hi;
};

__device__ __forceinline__ float lg2g(int h) { return h == 0 ? -0.045803689613125f : (h == 1 ? -0.022720076500083f : (h == 2 ? -0.011315313227834f : -0.005646563141142f)); }
__device__ __forceinline__ float fsigmoid(float x) { return 1.0f / (1.0f + __expf(-x)); }
__device__ __forceinline__ float fsilu(float x) { return x / (1.0f + __expf(-x)); }
__device__ __forceinline__ float bf2f(unsigned short b) { return __uint_as_float(((unsigned)b) << 16); }
__device__ __forceinline__ float bflo(unsigned w) { return __uint_as_float(w << 16); }
__device__ __forceinline__ float bfhi(unsigned w) { return __uint_as_float(w & 0xffff0000u); }
__device__ __forceinline__ u32x4 pack8(f32x4 a, f32x4 b) { u32x4 w; w.x = cvt_pk_bf16(a[0], a[1]); w.y = cvt_pk_bf16(a[2], a[3]); w.z = cvt_pk_bf16(b[0], b[1]); w.w = cvt_pk_bf16(b[2], b[3]); return w; }
__device__ __forceinline__ void unpack8(u32x4 w, f32x4& a, f32x4& b) { a = (f32x4){bflo(w.x), bfhi(w.x), bflo(w.y), bfhi(w.y)}; b = (f32x4){bflo(w.z), bfhi(w.z), bflo(w.w), bfhi(w.w)}; }

__device__ __forceinline__ int win_col(int nb) {
    const int n = nb * 64;
    if (n < 6144) return n;
    if (n < 10240) { const int w = n - 6144, j = w >> 8, seg = (w >> 6) & 3; const int base = seg == 0 ? 7168 : (seg == 1 ? 6144 : (seg == 2 ? 8192 : 10240)); return base + 64 * j; }
    return 9216 + (n - 10240);
}
__device__ __forceinline__ int wup_col(int nb) { const int pn = nb >> 2, sub = nb & 3; return sub < 2 ? 128 * pn + 64 * sub : 2816 + 128 * pn + 64 * (sub - 2); }

__device__ __forceinline__ void transpose_tile(const float* src, int ld, int k0, int c0, bf16_t* dst, int K, int n0, LAS float* t) {
    const int tid = threadIdx.x;
#pragma unroll
    for (int it = 0; it < 2; ++it) { const int idx = tid + it * 512, kr = idx >> 4, c4 = idx & 15;
        const f32x4 v = *(const f32x4*)(src + (size_t)(k0 + kr) * ld + c0 + c4 * 4);
        t[kr * 65 + c4 * 4 + 0] = v[0]; t[kr * 65 + c4 * 4 + 1] = v[1]; t[kr * 65 + c4 * 4 + 2] = v[2]; t[kr * 65 + c4 * 4 + 3] = v[3]; }
    __syncthreads();
    const int n = tid >> 3, kg = tid & 7;
    float f[8];
#pragma unroll
    for (int i = 0; i < 8; ++i) f[i] = t[(kg * 8 + i) * 65 + n];
    u32x4 w; w.x = cvt_pk_bf16(f[0], f[1]); w.y = cvt_pk_bf16(f[2], f[3]); w.z = cvt_pk_bf16(f[4], f[5]); w.w = cvt_pk_bf16(f[6], f[7]);
    *(u32x4*)(dst + (size_t)(n0 + n) * K + k0 + kg * 8) = w;
    __syncthreads();
}

__device__ __forceinline__ void phase_convert(const Params& p, LAS unsigned char* lds) {
    const size_t gtid = (size_t)blockIdx.x * 512 + threadIdx.x, gsz = (size_t)gridDim.x * 512;
    bf16_t* xb = (bf16_t*)(p.ws + WS_XB);
    for (size_t i = gtid; i < (size_t)NTOK * DM / 8; i += gsz) {
        const size_t e = i * 8; const float* src = e < (size_t)NP * DM ? p.x_prompt + e : p.x_sample + (e - (size_t)NP * DM);
        const f32x4 a = *(const f32x4*)src, b = *(const f32x4*)(src + 4);
        *(u32x4*)(xb + e) = pack8(a, b);
    }
    float* rope = (float*)(p.ws + WS_ROPE);
    for (size_t i = gtid; i < (size_t)2112 * 128; i += gsz) {
        const int pos = (int)(i >> 7), f = (int)(i & 127);
        const float lin = (float)f * (1.0f / 127.0f);
        const float inv = 1.0f / exp2f(lin * 13.287712379549449f);
        const float ang = (float)pos * inv;
        const double a = (double)ang; const double n = rint(a * 0.15915494309189535); const float r = (float)(a - n * 6.283185307179586);
        rope[(size_t)pos * 256 + f] = __cosf(r); rope[(size_t)pos * 256 + 128 + f] = __sinf(r);
    }
    LAS float* t = (LAS float*)lds;
    constexpr int T_IN = 16 * 176, T_R = 32 * 16, T_C = 16 * 16, T_O = 16 * 16, T_UP = 16 * 88, T_D = 44 * 16;
    constexpr int TT = T_IN + T_R + T_C + T_O + T_UP + T_D;
    for (int ti = blockIdx.x; ti < TT; ti += gridDim.x) {
        int x = ti;
        if (x < T_IN) { const int nb = x >> 4, kb = x & 15; transpose_tile(p.w_in, 11264, kb * 64, win_col(nb), (bf16_t*)(p.ws + WS_WIN), 1024, nb * 64, t); continue; } x -= T_IN;
        if (x < T_R) { const int nb = x >> 5, kb = x & 31; transpose_tile(p.w_ret_out, 1024, kb * 64, nb * 64, (bf16_t*)(p.ws + WS_WR), 2048, nb * 64, t); continue; } x -= T_R;
        if (x < T_C) { const int nb = x >> 4, kb = x & 15; transpose_tile(p.w_conv_out, 1024, kb * 64, nb * 64, (bf16_t*)(p.ws + WS_WC), 1024, nb * 64, t); continue; } x -= T_C;
        if (x < T_O) { const int nb = x >> 4, kb = x & 15; transpose_tile(p.w_o, 1024, kb * 64, nb * 64, (bf16_t*)(p.ws + WS_WO), 1024, nb * 64, t); continue; } x -= T_O;
        if (x < T_UP) { const int nb = x >> 4, kb = x & 15; transpose_tile(p.w_up, 5632, kb * 64, wup_col(nb), (bf16_t*)(p.ws + WS_WUP), 1024, nb * 64, t); continue; } x -= T_UP;
        { const int nb = x / 44, kb = x % 44; transpose_tile(p.w_down, 1024, kb * 64, nb * 64, (bf16_t*)(p.ws + WS_WD), 2816, nb * 64, t); }
    }
}

__device__ __forceinline__ int row_pos(int r) { return r < NP ? (r & 2047) : 2048 + ((r - NP) & 63); }

struct Epi1a {
    static constexpr bool PERM = true, AFTER_DRAIN = false;
    bf16_t *qb, *kb, *vb; const float* rope;
    __device__ __forceinline__ void operator()(const f32x4 (&acc)[2][2][4][2], const Unit& u, int wr, int wc, int fr, int fq) const {
        const int row0 = u.pm * BM + wr * 64 + fr;
        if (u.pn < 8) {
            const bool isq = u.pn < 4; const int h = u.pn & 3; const float lg = lg2g(h);
            bf16_t* base = (isq ? qb : kb) + h * 256;
            const int d0 = wc * 32 + 8 * fq;
#pragma unroll
            for (int ai = 0; ai < 2; ++ai)
#pragma unroll
                for (int m = 0; m < 4; ++m) {
                    const int r = row0 + ai * HALF + m * 16;
                    const float sc = isq ? exp2f(lg * (float)((r & 63) + 1)) : 0.0625f;
                    const float* tc = rope + (size_t)row_pos(r) * 256 + d0;
                    const f32x4 c0 = *(const f32x4*)tc, c1 = *(const f32x4*)(tc + 4), s0 = *(const f32x4*)(tc + 128), s1 = *(const f32x4*)(tc + 132);
                    const f32x4 x1a = acc[ai][0][m][0], x1b = acc[ai][0][m][1], x2a = acc[ai][1][m][0], x2b = acc[ai][1][m][1];
                    const f32x4 o1a = (x1a * c0 - x2a * s0) * sc, o1b = (x1b * c1 - x2b * s1) * sc;
                    const f32x4 o2a = (x1a * s0 + x2a * c0) * sc, o2b = (x1b * s1 + x2b * c1) * sc;
                    bf16_t* rp = base + (size_t)r * 1024 + d0;
                    *(u32x4*)rp = pack8(o1a, o1b); *(u32x4*)(rp + 128) = pack8(o2a, o2b);
                }
        } else {
            const int cv = (u.pn - 8) * 256, h = cv >> 9; const float lg = lg2g(h);
#pragma unroll
            for (int ai = 0; ai < 2; ++ai)
#pragma unroll
                for (int m = 0; m < 4; ++m) {
                    const int r = row0 + ai * HALF + m * 16;
                    const float sc = exp2f(lg * (float)(63 - (r & 63)));
                    bf16_t* rp = vb + (size_t)r * 2048 + cv + wc * 32 + 8 * fq;
#pragma unroll
                    for (int bj = 0; bj < 2; ++bj) *(u32x4*)(rp + bj * HALF) = pack8(acc[ai][bj][m][0] * sc, acc[ai][bj][m][1] * sc);
                }
        }
    }
};

struct Epi1b {
    static constexpr bool PERM = true, AFTER_DRAIN = false;
    bf16_t *ob, *cbb, *ub, *sgrb, *sgcb; const float* ssq; float* out;
    __device__ __forceinline__ void operator()(const f32x4 (&acc)[2][2][4][2], const Unit& u, int wr, int wc, int fr, int fq) const {
        const int row0 = u.pm * BM + wr * 64 + fr;
        if (u.pn < 8) {
            const int h = u.pn >> 1, col = u.pn * 256 + wc * 32 + 8 * fq;
#pragma unroll
            for (int ai = 0; ai < 2; ++ai)
#pragma unroll
                for (int m = 0; m < 4; ++m) {
                    const int r = row0 + ai * HALF + m * 16;
                    const f32x4* sp = (const f32x4*)(ssq + (size_t)r * 64 + h * 16);
                    const f32x4 t4 = (sp[0] + sp[1]) + (sp[2] + sp[3]);
                    const float rstd = rsqrtf(((t4[0] + t4[1]) + (t4[2] + t4[3])) * (1.0f / 512.0f) + 1e-6f);
                    bf16_t* rp = ob + (size_t)r * 2048 + col;
#pragma unroll
                    for (int bj = 0; bj < 2; ++bj) {
                        f32x4 oa, obv; unpack8(*(const u32x4*)(rp + bj * HALF), oa, obv);
                        f32x4 ga = acc[ai][bj][m][0], gb = acc[ai][bj][m][1];
#pragma unroll
                        for (int j = 0; j < 4; ++j) { ga[j] = fsilu(ga[j]) * oa[j] * rstd; gb[j] = fsilu(gb[j]) * obv[j] * rstd; }
                        *(u32x4*)(rp + bj * HALF) = pack8(ga, gb);
                    }
                }
        } else if (u.pn < 24) {
            const int j64 = (u.pn - 8) * 64;
            if (wc < 2) {
                const int col = j64 + wc * 32 + 8 * fq;
#pragma unroll
                for (int ai = 0; ai < 2; ++ai)
#pragma unroll
                    for (int m = 0; m < 4; ++m) {
                        const int r = row0 + ai * HALF + m * 16;
                        const f32x4 ua = acc[ai][0][m][0] * acc[ai][1][m][0], uv = acc[ai][0][m][1] * acc[ai][1][m][1];
                        *(u32x4*)(ub + (size_t)r * 1024 + col) = pack8(ua, uv);
                        if (r < NP) { const int pos = r & 2047; if (pos >= 2046) { float* cp = out + OUT_CP + ((size_t)(r >> 11) * 2 + (pos - 2046)) * 1024 + col; *(f32x4*)cp = ua; *(f32x4*)(cp + 4) = uv; } }
                        else { const int s = r - NP, pos = s & 63; if (pos >= 62) { float* cp = out + OUT_CS + ((size_t)(s >> 6) * 2 + (pos - 62)) * 1024 + col; *(f32x4*)cp = ua; *(f32x4*)(cp + 4) = uv; } }
                    }
            } else {
                const int col = j64 + (wc - 2) * 32 + 8 * fq;
#pragma unroll
                for (int ai = 0; ai < 2; ++ai)
#pragma unroll
                    for (int m = 0; m < 4; ++m) {
                        const int r = row0 + ai * HALF + m * 16;
                        *(u32x4*)(cbb + (size_t)r * 1024 + col) = pack8(acc[ai][0][m][0], acc[ai][0][m][1]);
                        f32x4 ga = acc[ai][1][m][0], gb = acc[ai][1][m][1];
#pragma unroll
                        for (int j = 0; j < 4; ++j) { ga[j] = fsigmoid(ga[j]); gb[j] = fsigmoid(gb[j]); }
                        *(u32x4*)(sgcb + (size_t)r * 1024 + col) = pack8(ga, gb);
                    }
            }
        } else {
            const int col = (u.pn - 24) * 256 + wc * 32 + 8 * fq;
#pragma unroll
            for (int ai = 0; ai < 2; ++ai)
#pragma unroll
                for (int m = 0; m < 4; ++m) {
                    const int r = row0 + ai * HALF + m * 16;
#pragma unroll
                    for (int bj = 0; bj < 2; ++bj) {
                        f32x4 ga = acc[ai][bj][m][0], gb = acc[ai][bj][m][1];
#pragma unroll
                        for (int j = 0; j < 4; ++j) { ga[j] = fsigmoid(ga[j]); gb[j] = fsigmoid(gb[j]); }
                        *(u32x4*)(sgrb + (size_t)r * 1024 + col + bj * HALF) = pack8(ga, gb);
                    }
                }
        }
    }
};

template <int SECOND> struct EpiMerge {
    static constexpr bool PERM = true, AFTER_DRAIN = false;
    bf16_t* mb; const bf16_t* gate;
    __device__ __forceinline__ void operator()(const f32x4 (&acc)[2][2][4][2], const Unit& u, int wr, int wc, int fr, int fq) const {
        const int row0 = u.pm * BM + wr * 64 + fr, col = u.pn * BM + wc * 32 + 8 * fq;
#pragma unroll
        for (int ai = 0; ai < 2; ++ai)
#pragma unroll
            for (int m = 0; m < 4; ++m) {
                const size_t off = (size_t)(row0 + ai * HALF + m * 16) * 1024 + col;
#pragma unroll
                for (int bj = 0; bj < 2; ++bj) {
                    f32x4 ga, gb; unpack8(*(const u32x4*)(gate + off + bj * HALF), ga, gb);
                    f32x4 va = acc[ai][bj][m][0] * ga, vb = acc[ai][bj][m][1] * gb;
                    if (SECOND) { f32x4 pa, pb; unpack8(*(const u32x4*)(mb + off + bj * HALF), pa, pb); va += pa; vb += pb; }
                    *(u32x4*)(mb + off + bj * HALF) = pack8(va, vb);
                }
            }
    }
};

struct EpiRes {
    static constexpr bool PERM = false, AFTER_DRAIN = false;
    const float* base_p; const float* base_s; float* o;
    __device__ __forceinline__ void operator()(const f32x4 (&acc)[2][2][4][2], const Unit& u, int wr, int wc, int fr, int fq) const {
        const int row0 = u.pm * BM + wr * 64 + fr, col0 = u.pn * BM + wc * 32 + 4 * fq;
#pragma unroll
        for (int ai = 0; ai < 2; ++ai)
#pragma unroll
            for (int m = 0; m < 4; ++m) {
                const int r = row0 + ai * HALF + m * 16;
                const float* bp = (r < NP ? base_p + (size_t)r * 1024 : base_s + (size_t)(r - NP) * 1024) + col0;
                float* op = o + (size_t)r * 1024 + col0;
#pragma unroll
                for (int bj = 0; bj < 2; ++bj)
#pragma unroll
                    for (int n = 0; n < 2; ++n) { const f32x4 bs = *(const f32x4*)(bp + bj * HALF + n * 16); *(f32x4*)(op + bj * HALF + n * 16) = bs * ALPHA + acc[ai][bj][m][n]; }
            }
    }
};

struct EpiUp {
    static constexpr bool PERM = true, AFTER_DRAIN = false;
    bf16_t* fb;
    __device__ __forceinline__ void operator()(const f32x4 (&acc)[2][2][4][2], const Unit& u, int wr, int wc, int fr, int fq) const {
        const int row0 = u.pm * BM + wr * 64 + fr, col = u.pn * 128 + wc * 32 + 8 * fq;
#pragma unroll
        for (int ai = 0; ai < 2; ++ai)
#pragma unroll
            for (int m = 0; m < 4; ++m) {
                f32x4 va = acc[ai][0][m][0], vb = acc[ai][0][m][1];
#pragma unroll
                for (int j = 0; j < 4; ++j) { va[j] = fsilu(va[j]) * acc[ai][1][m][0][j]; vb[j] = fsilu(vb[j]) * acc[ai][1][m][1][j]; }
                *(u32x4*)(fb + (size_t)(row0 + ai * HALF + m * 16) * DFF + col) = pack8(va, vb);
            }
    }
};

__device__ __forceinline__ bf16x8 mk8(s16x4 lo, s16x4 hi) { return __builtin_shufflevector(lo, hi, 0, 1, 2, 3, 4, 5, 6, 7); }
__device__ __forceinline__ bf16x8 trfrag(LAS unsigned char* img, int stride, int krow0, int col0, int lane) {
    const int g = lane >> 4, q = (lane & 15) >> 2, pp = lane & 3;
    LAS unsigned char* a = img + (krow0 + 8 * g + q) * stride + (col0 + 4 * pp) * 2;
    const s16x4 lo = __builtin_amdgcn_ds_read_tr16_b64_v4i16((LAS s16x4*)a);
    const s16x4 hi = __builtin_amdgcn_ds_read_tr16_b64_v4i16((LAS s16x4*)(a + 4 * stride));
    return mk8(lo, hi);
}
#define MFMA16(a, b, c) __builtin_amdgcn_mfma_f32_16x16x32_bf16((a), (b), (c), 0, 0, 0)

__device__ __forceinline__ void phase_retention(const Params& p, LAS unsigned char* lds) {
    const int tid = threadIdx.x, wid = __builtin_amdgcn_readfirstlane(tid >> 6), lane = tid & 63, fr = lane & 15, fq = lane >> 4;
    constexpr int QS = 528, VS = 144;
    constexpr int OFF_Q = 0, OFF_K = 33792, OFF_V = 67584, OFF_P = 76800, OFF_S = 86016;
    const bf16_t* qb = (const bf16_t*)(p.ws + WS_Q); const bf16_t* kb = (const bf16_t*)(p.ws + WS_K); const bf16_t* vb = (const bf16_t*)(p.ws + WS_V);
    bf16_t* ob = (bf16_t*)p.out; float* ssq = (float*)(p.ws + WS_SSQ);
    const int lrow = tid >> 3, piece = tid & 7;
    for (int item = blockIdx.x; item < 1280; item += gridDim.x) {
        int b, h, es, nsteps; size_t row0; const float* S0; float* Sout;
        if (item < 256) { const int xcd = item & 7, idx = item >> 3, bh = xcd * 4 + (idx >> 3); es = idx & 7; b = bh >> 2; h = bh & 3; nsteps = 32; row0 = (size_t)b * 2048; S0 = nullptr;
            Sout = p.out + OUT_SP + ((size_t)(b * 4 + h) * 256) * 512 + es * 64; }
        else { const int s = item - 256, xcd = s & 7, idx = s >> 3, bh = xcd * 16 + (idx >> 3); es = idx & 7; b = bh >> 2; h = bh & 3; nsteps = 1; row0 = (size_t)NP + (size_t)b * 64;
            S0 = p.state_ret + ((size_t)(b * 4 + h) * 256) * 512 + es * 64; Sout = p.out + OUT_SS + ((size_t)(b * 4 + h) * 256) * 512 + es * 64; }
        const float lg = lg2g(h), carry = exp2f(64.0f * lg);
        f32x4 Sacc[4][2];
#pragma unroll
        for (int et = 0; et < 4; ++et)
#pragma unroll
            for (int dt = 0; dt < 2; ++dt) {
                const int d = 32 * wid + 16 * dt + fr, e = 16 * et + 4 * fq;
                Sacc[et][dt] = S0 ? *(const f32x4*)(S0 + (size_t)d * 512 + e) : (f32x4){0.f, 0.f, 0.f, 0.f};
                u32x2 w; w.x = cvt_pk_bf16(Sacc[et][dt][0], Sacc[et][dt][1]); w.y = cvt_pk_bf16(Sacc[et][dt][2], Sacc[et][dt][3]);
                *(LAS u32x2*)(lds + OFF_S + d * VS + e * 2) = w;
            }
        u32x4 pq[4], pk[4], pv;
        {   const size_t r = row0 + lrow;
#pragma unroll
            for (int it = 0; it < 4; ++it) { pq[it] = *(const u32x4*)(qb + r * 1024 + h * 256 + (piece + 8 * it) * 8); pk[it] = *(const u32x4*)(kb + r * 1024 + h * 256 + (piece + 8 * it) * 8); }
            pv = *(const u32x4*)(vb + r * 2048 + h * 512 + es * 64 + piece * 8); }
        for (int step = 0; step < nsteps; ++step) {
#pragma unroll
            for (int it = 0; it < 4; ++it) { *(LAS u32x4*)(lds + OFF_Q + lrow * QS + (piece + 8 * it) * 16) = pq[it]; *(LAS u32x4*)(lds + OFF_K + lrow * QS + (piece + 8 * it) * 16) = pk[it]; }
            *(LAS u32x4*)(lds + OFF_V + lrow * VS + piece * 16) = pv;
            __syncthreads();
            if (step + 1 < nsteps) { const size_t r = row0 + (size_t)(step + 1) * 64 + lrow;
#pragma unroll
                for (int it = 0; it < 4; ++it) { pq[it] = *(const u32x4*)(qb + r * 1024 + h * 256 + (piece + 8 * it) * 8); pk[it] = *(const u32x4*)(kb + r * 1024 + h * 256 + (piece + 8 * it) * 8); }
                pv = *(const u32x4*)(vb + r * 2048 + h * 512 + es * 64 + piece * 8); }
            const int it_ = wid >> 1, c0 = (wid & 1) * 2;
            {   f32x4 sacc[2] = {{0.f, 0.f, 0.f, 0.f}, {0.f, 0.f, 0.f, 0.f}};
#pragma unroll
                for (int kk = 0; kk < 8; ++kk) {
                    const bf16x8 qf = *(const LAS bf16x8*)(lds + OFF_Q + (16 * it_ + fr) * QS + kk * 64 + fq * 16);
#pragma unroll
                    for (int t = 0; t < 2; ++t) { const bf16x8 kf = *(const LAS bf16x8*)(lds + OFF_K + (16 * (c0 + t) + fr) * QS + kk * 64 + fq * 16); sacc[t] = MFMA16(kf, qf, sacc[t]); }
                }
                const int i = 16 * it_ + fr;
#pragma unroll
                for (int t = 0; t < 2; ++t) { const int j0 = 16 * (c0 + t) + 4 * fq; float v[4];
#pragma unroll
                    for (int jj = 0; jj < 4; ++jj) { const int j = j0 + jj; const int ex = (j <= i) ? -64 : 2 * (j - i) - 64; v[jj] = sacc[t][jj] * exp2f(lg * (float)ex); }
                    u32x2 w; w.x = cvt_pk_bf16(v[0], v[1]); w.y = cvt_pk_bf16(v[2], v[3]);
                    *(LAS u32x2*)(lds + OFF_P + i * VS + j0 * 2) = w; }
            }
            __syncthreads();
            {   f32x4 oacc[2] = {{0.f, 0.f, 0.f, 0.f}, {0.f, 0.f, 0.f, 0.f}};
#pragma unroll
                for (int kk = 0; kk < 2; ++kk) {
                    const bf16x8 pf = *(const LAS bf16x8*)(lds + OFF_P + (16 * it_ + fr) * VS + kk * 64 + fq * 16);
#pragma unroll
                    for (int t = 0; t < 2; ++t) { const bf16x8 vf = trfrag(lds + OFF_V, VS, 32 * kk, 16 * (c0 + t), lane); oacc[t] = MFMA16(vf, pf, oacc[t]); }
                }
#pragma unroll
                for (int kk = 0; kk < 8; ++kk) {
                    const bf16x8 qf = *(const LAS bf16x8*)(lds + OFF_Q + (16 * it_ + fr) * QS + kk * 64 + fq * 16);
#pragma unroll
                    for (int t = 0; t < 2; ++t) { const bf16x8 sf = trfrag(lds + OFF_S, VS, 32 * kk, 16 * (c0 + t), lane); oacc[t] = MFMA16(sf, qf, oacc[t]); }
                }
                const size_t r = row0 + (size_t)step * 64 + 16 * it_ + fr;
                float ss = 0.f;
#pragma unroll
                for (int t = 0; t < 2; ++t) { const f32x4 o = oacc[t]; ss += (o[0] * o[0] + o[1] * o[1]) + (o[2] * o[2] + o[3] * o[3]);
                    u32x2 w; w.x = cvt_pk_bf16(o[0], o[1]); w.y = cvt_pk_bf16(o[2], o[3]);
                    *(u32x2*)(ob + r * 2048 + h * 512 + es * 64 + 16 * (c0 + t) + 4 * fq) = w; }
                ss += __shfl_xor(ss, 16); ss += __shfl_xor(ss, 32);
                if (fq == 0) ssq[r * 64 + h * 16 + es * 2 + (wid & 1)] = ss;
            }
            {
#pragma unroll
                for (int et = 0; et < 4; ++et)
#pragma unroll
                    for (int dt = 0; dt < 2; ++dt) Sacc[et][dt] *= carry;
#pragma unroll
                for (int kk = 0; kk < 2; ++kk) {
                    bf16x8 kf[2];
#pragma unroll
                    for (int dt = 0; dt < 2; ++dt) kf[dt] = trfrag(lds + OFF_K, QS, 32 * kk, 32 * wid + 16 * dt, lane);
#pragma unroll
                    for (int et = 0; et < 4; ++et) { const bf16x8 vf = trfrag(lds + OFF_V, VS, 32 * kk, 16 * et, lane);
#pragma unroll
                        for (int dt = 0; dt < 2; ++dt) Sacc[et][dt] = MFMA16(vf, kf[dt], Sacc[et][dt]); }
                }
            }
            __syncthreads();
            if (step + 1 < nsteps) {
#pragma unroll
                for (int et = 0; et < 4; ++et)
#pragma unroll
                    for (int dt = 0; dt < 2; ++dt) { const int d = 32 * wid + 16 * dt + fr, e = 16 * et + 4 * fq;
                        u32x2 w; w.x = cvt_pk_bf16(Sacc[et][dt][0], Sacc[et][dt][1]); w.y = cvt_pk_bf16(Sacc[et][dt][2], Sacc[et][dt][3]);
                        *(LAS u32x2*)(lds + OFF_S + d * VS + e * 2) = w; }
            }
        }
#pragma unroll
        for (int et = 0; et < 4; ++et)
#pragma unroll
            for (int dt = 0; dt < 2; ++dt) { const int d = 32 * wid + 16 * dt + fr, e = 16 * et + 4 * fq; *(f32x4*)(Sout + (size_t)d * 512 + e) = Sacc[et][dt]; }
    }
}

__device__ __forceinline__ void phase_conv(const Params& p) {
    const size_t gtid = (size_t)blockIdx.x * 512 + threadIdx.x, gsz = (size_t)gridDim.x * 512;
    bf16_t* cbb = (bf16_t*)(p.ws + WS_Q); const bf16_t* ub = (const bf16_t*)(p.ws + WS_K);
    for (size_t idx = gtid; idx < (size_t)NTOK * 128; idx += gsz) {
        const int r = (int)(idx >> 7), c = (int)(idx & 127) * 8;
        const bool smp = r >= NP; const int pos = smp ? ((r - NP) & 63) : (r & 2047);
        f32x4 u0a, u0b, u1a, u1b, u2a, u2b;
        unpack8(*(const u32x4*)(ub + (size_t)r * 1024 + c), u2a, u2b);
        const float* cache = smp ? p.cache_conv + (size_t)((r - NP) >> 6) * 2048 + c : nullptr;
        if (pos >= 1) unpack8(*(const u32x4*)(ub + (size_t)(r - 1) * 1024 + c), u1a, u1b);
        else if (smp) { u1a = *(const f32x4*)(cache + 1024); u1b = *(const f32x4*)(cache + 1024 + 4); }
        else { u1a = (f32x4){0.f, 0.f, 0.f, 0.f}; u1b = u1a; }
        if (pos >= 2) unpack8(*(const u32x4*)(ub + (size_t)(r - 2) * 1024 + c), u0a, u0b);
        else if (smp) { u0a = *(const f32x4*)(cache + pos * 1024); u0b = *(const f32x4*)(cache + pos * 1024 + 4); }
        else { u0a = (f32x4){0.f, 0.f, 0.f, 0.f}; u0b = u0a; }
        const f32x4 w0a = *(const f32x4*)(p.w_conv + c), w0b = *(const f32x4*)(p.w_conv + c + 4);
        const f32x4 w1a = *(const f32x4*)(p.w_conv + 1024 + c), w1b = *(const f32x4*)(p.w_conv + 1024 + c + 4);
        const f32x4 w2a = *(const f32x4*)(p.w_conv + 2048 + c), w2b = *(const f32x4*)(p.w_conv + 2048 + c + 4);
        f32x4 ca, cbv; unpack8(*(const u32x4*)(cbb + (size_t)r * 1024 + c), ca, cbv);
        const f32x4 ra = ca * (w0a * u0a + w1a * u1a + w2a * u2a), rb = cbv * (w0b * u0b + w1b * u1b + w2b * u2b);
        *(u32x4*)(cbb + (size_t)r * 1024 + c) = pack8(ra, rb);
    }
}

__device__ __forceinline__ void phase_ln(float* x, const float* g, const float* bta, bf16_t* xb) {
    const int lane = threadIdx.x & 63, wv = (blockIdx.x * 512 + threadIdx.x) >> 6, nwv = gridDim.x * 8;
    f32x4 gg[4], bb[4];
#pragma unroll
    for (int i = 0; i < 4; ++i) { gg[i] = *(const f32x4*)(g + i * 256 + lane * 4); bb[i] = *(const f32x4*)(bta + i * 256 + lane * 4); }
    for (int r = wv; r < NTOK; r += nwv) {
        float* rp = x + (size_t)r * 1024 + lane * 4;
        f32x4 v[4]; float s = 0.f;
#pragma unroll
        for (int i = 0; i < 4; ++i) { v[i] = *(const f32x4*)(rp + i * 256); s += (v[i][0] + v[i][1]) + (v[i][2] + v[i][3]); }
#pragma unroll
        for (int o = 32; o >= 1; o >>= 1) s += __shfl_xor(s, o);
        const float mu = s * (1.0f / 1024.0f); float q = 0.f;
#pragma unroll
        for (int i = 0; i < 4; ++i) { v[i] -= mu; q += (v[i][0] * v[i][0] + v[i][1] * v[i][1]) + (v[i][2] * v[i][2] + v[i][3] * v[i][3]); }
#pragma unroll
        for (int o = 32; o >= 1; o >>= 1) q += __shfl_xor(q, o);
        const float rstd = rsqrtf(q * (1.0f / 1024.0f) + 1e-5f);
#pragma unroll
        for (int i = 0; i < 4; ++i) { const f32x4 y = v[i] * rstd * gg[i] + bb[i]; *(f32x4*)(rp + i * 256) = y;
            if (xb) { u32x2 w; w.x = cvt_pk_bf16(y[0], y[1]); w.y = cvt_pk_bf16(y[2], y[3]); *(u32x2*)(xb + (size_t)r * 1024 + i * 256 + lane * 4) = w; } }
    }
}

template <class Epi> __device__ __forceinline__ void run_gemm(LAS unsigned char* lds, Gemm g, Epi E) {
    StaticOrder S; S.init(g.M, g.N, (int)gridDim.x, (int)blockIdx.x); gemm_phase<Epi, StaticOrder>(lds, g, S, E, nullptr);
}
constexpr int NPHASE = 11;
__global__ void __launch_bounds__(512, 2) mega(Params p) {
    extern __shared__ __attribute__((aligned(16))) unsigned char lds_raw[];
    LAS unsigned char* lds = (LAS unsigned char*)lds_raw;
    cg::grid_group grid = cg::this_grid();
    unsigned char* ws = p.ws;
#if MK_LAUNCHES == 1
#define RUN(k) true
#define SYNC() grid.sync()
#else
#define RUN(k) (p.ph_lo == (k))
#define SYNC() do {} while (0)
#endif
    if (RUN(0)) phase_convert(p, lds);
    SYNC();
    if (RUN(1)) { Gemm g{(const bf16_t*)(ws + WS_XB), (const bf16_t*)(ws + WS_WIN), NTOK, 4096, 1024}; Epi1a E{(bf16_t*)(ws + WS_Q), (bf16_t*)(ws + WS_K), (bf16_t*)(ws + WS_V), (const float*)(ws + WS_ROPE)}; run_gemm<Epi1a>(lds, g, E); }
    SYNC();
    if (RUN(2)) phase_retention(p, lds);
    SYNC();
    if (RUN(3)) { Gemm g{(const bf16_t*)(ws + WS_XB), (const bf16_t*)(ws + WS_WIN) + (size_t)4096 * 1024, NTOK, 7168, 1024}; Epi1b E{(bf16_t*)p.out, (bf16_t*)(ws + WS_Q), (bf16_t*)(ws + WS_K), (bf16_t*)(ws + WS_V), (bf16_t*)(ws + WS_V) + (size_t)NTOK * 1024, (const float*)(ws + WS_SSQ), p.out}; run_gemm<Epi1b>(lds, g, E); }
    SYNC();
    if (RUN(4)) phase_conv(p);
    SYNC();
    if (RUN(5)) {
        { Gemm g{(const bf16_t*)p.out, (const bf16_t*)(ws + WS_WR), NTOK, 1024, 2048}; EpiMerge<0> E{(bf16_t*)(ws + WS_XB), (const bf16_t*)(ws + WS_V)}; run_gemm<EpiMerge<0>>(lds, g, E); }
        { Gemm g{(const bf16_t*)(ws + WS_Q), (const bf16_t*)(ws + WS_WC), NTOK, 1024, 1024}; EpiMerge<1> E{(bf16_t*)(ws + WS_XB), (const bf16_t*)(ws + WS_V) + (size_t)NTOK * 1024}; run_gemm<EpiMerge<1>>(lds, g, E); }
    }
    SYNC();
    if (RUN(6)) { Gemm g{(const bf16_t*)(ws + WS_XB), (const bf16_t*)(ws + WS_WO), NTOK, 1024, 1024}; EpiRes E{p.x_prompt, p.x_sample, p.out}; run_gemm<EpiRes>(lds, g, E); }
    SYNC();
    if (RUN(7)) phase_ln(p.out, p.ln1_g, p.ln1_b, (bf16_t*)(ws + WS_XB));
    SYNC();
    if (RUN(8)) { Gemm g{(const bf16_t*)(ws + WS_XB), (const bf16_t*)(ws + WS_WUP), NTOK, 5632, 1024}; EpiUp E{(bf16_t*)(ws + WS_Q)}; run_gemm<EpiUp>(lds, g, E); }
    SYNC();
    if (RUN(9)) { Gemm g{(const bf16_t*)(ws + WS_Q), (const bf16_t*)(ws + WS_WD), NTOK, 1024, 2816}; EpiRes E{p.out, p.out + (size_t)NP * 1024, p.out}; run_gemm<EpiRes>(lds, g, E); }
    SYNC();
    if (RUN(10)) phase_ln(p.out, p.ln2_g, p.ln2_b, nullptr);
}

constexpr int LDS_BYTES = 131072;
extern "C" void kernel_launch(void* const* d_in, const int* in_sizes, int n_in, void* d_out, int out_size, void* d_ws, size_t ws_size, hipStream_t stream) {
    static int grid = 0;
    if (grid == 0) {
        if (n_in != 15 || ws_size < WS_END) { fprintf(stderr, "kernel_launch: need 15 inputs and %zu bytes of workspace; got %d, %zu\n", (size_t)WS_END, n_in, ws_size); grid = -1; return; }
        int dev = 0, cus = 0, per_cu = 0;
        hipGetDevice(&dev); hipDeviceGetAttribute(&cus, hipDeviceAttributeMultiprocessorCount, dev);
        if (hipFuncSetAttribute((const void*)mega, hipFuncAttributeMaxDynamicSharedMemorySize, LDS_BYTES) != hipSuccess) { fprintf(stderr, "kernel_launch: hipFuncSetAttribute failed\n"); grid = -1; return; }
        if (hipOccupancyMaxActiveBlocksPerMultiprocessor(&per_cu, (const void*)mega, 512, LDS_BYTES) != hipSuccess || per_cu < 1) { fprintf(stderr, "kernel_launch: occupancy query says %d\n", per_cu); per_cu = 1; }
        (void)hipGetLastError();
        grid = cus;
        fprintf(stderr, "kernel_launch: grid %d (per_cu %d)\n", grid, per_cu);
    }
    if (grid < 0) return;
    Params p{};
    p.x_prompt = (const float*)d_in[0]; p.x_sample = (const float*)d_in[1]; p.state_ret = (const float*)d_in[2]; p.cache_conv = (const float*)d_in[3];
    p.w_in = (const float*)d_in[4]; p.w_conv = (const float*)d_in[5]; p.w_ret_out = (const float*)d_in[6]; p.w_conv_out = (const float*)d_in[7]; p.w_o = (const float*)d_in[8];
    p.ln1_g = (const float*)d_in[9]; p.ln1_b = (const float*)d_in[10]; p.w_up = (const float*)d_in[11]; p.w_down = (const float*)d_in[12]; p.ln2_g = (const float*)d_in[13]; p.ln2_b = (const float*)d_in[14];
    p.out = (float*)d_out; p.ws = (unsigned char*)d_ws;
#if MK_LAUNCHES == 1
    p.ph_lo = 0; p.ph_hi = NPHASE;
    void* args[] = {&p};
    hipError_t e = hipLaunchCooperativeKernel((const void*)mega, dim3(grid), dim3(512), args, LDS_BYTES, stream);
    if (e != hipSuccess) fprintf(stderr, "cooperative launch failed: %s (grid %d)\n", hipGetErrorString(e), grid);
#else
    for (int ph = 0; ph < NPHASE; ++ph) { p.ph_lo = ph; p.ph_hi = ph + 1; hipLaunchKernelGGL(mega, dim3(grid), dim3(512), LDS_BYTES, stream, p); }
#endif
}
```

```cpp
#include <hip/hip_runtime.h>
#include <hip/hip_cooperative_groups.h>
#include <cstdio>
namespace cg = cooperative_groups;
#ifndef MK_LAUNCHES
#define MK_LAUNCHES 1
#endif
namespace pg8 {
#define PG8_LAS __attribute__((address_space(3)))
typedef unsigned short bf16_t;
typedef short bf16x8 __attribute__((ext_vector_type(8)));
typedef float f32x4 __attribute__((ext_vector_type(4)));
typedef unsigned u32x4 __attribute__((ext_vector_type(4)));
constexpr int BM = 256, BK = 64, HALF = 128, HTB = HALF * BK * 2  , STAGE_BYTES = 8 * HTB, NXCD = 8, WGM = 8;

__host__ __device__ __forceinline__ int lds_byte(int r, int c) { const int st = (r >> 4) * 2 + (c >> 5), rr = r & 15, cc = c & 31, ob = rr * 64 + cc * 2; return st * 1024 + (ob ^ (((ob >> 9) & 1) << 5)); }
__host__ __device__ __forceinline__ void stage_rc(int b, int& R, int& C) { const int st = b / 1024, sb = b % 1024, swz = sb ^ (((sb >> 9) & 1) << 5); R = (st >> 1) * 16 + swz / 64; C = (st & 1) * 32 + (swz % 64) / 2; }
__host__ __device__ __forceinline__ int perm32(int rho) { const int n = rho >> 4, i = rho & 15; return 8 * (i >> 2) + 4 * n + (i & 3); }

struct Unit { int pm, pn; };
struct Gemm { const bf16_t* A; const bf16_t* Bt; int M, N, K; int ld; };

struct StaticOrder {
    int nM, nN, nwg, G, c;
    __host__ __device__ void init(int M, int N, int G_, int c_) { nM = M / BM; nN = N / BM; nwg = nM * nN; G = G_; c = c_; }
    __host__ __device__ bool next(int i, Unit& u) const {
        const long L = (long)i * G + c; if (L >= nwg) return false;
        int wgid = (int)L; { const int q = nwg / NXCD, r = nwg % NXCD, xcd = wgid % NXCD, off = wgid / NXCD; wgid = (xcd < r ? xcd * (q + 1) : r * (q + 1) + (xcd - r) * q) + off; }
        const int nig = WGM * nN, gid = wgid / nig, fm = gid * WGM, gsz = (nM - fm) < WGM ? (nM - fm) : WGM;
        u.pm = fm + ((wgid % nig) % gsz); u.pn = (wgid % nig) / gsz; return true;
    }
    __device__ __forceinline__ void a_ready(const Unit&) const {}
    __device__ __forceinline__ void done(const Unit&) const {}
};
typedef __bf16 bf16x2_t __attribute__((ext_vector_type(2)));
typedef float f32x2_t __attribute__((ext_vector_type(2)));
__device__ __forceinline__ unsigned cvt_pk_bf16(float lo, float hi) { const f32x2_t v = {lo, hi}; return __builtin_bit_cast(unsigned, __builtin_convertvector(v, bf16x2_t)); }
template <class Epi, class Sched, bool STAMP = false>
__device__ __forceinline__ void gemm_phase(PG8_LAS unsigned char* lds, const Gemm g, const Sched& S, const Epi& E, unsigned long long* stamps) {
    int tid_ = threadIdx.x; asm volatile("" : "+v"(tid_));
    const int tid = tid_, wid = __builtin_amdgcn_readfirstlane(tid >> 6), lane = tid & 63, wr = wid >> 2, wc = wid & 3, fr = lane & 15, fq = lane >> 4;
    const int K = g.K, nt = K / BK, LD = g.ld ? g.ld : g.K;
    int ts_lo = 0, ts_hi = 0, nts = 0; const unsigned long long rt_entry = STAMP ? (unsigned long long)wall_clock64() : 0ull;
#define PG8_STAMP() do { if (STAMP && wid == 0 && nts < 64) { const unsigned long long _c = (unsigned long long)clock64(); \
        ts_lo = (lane == nts) ? (int)(unsigned)_c : ts_lo; ts_hi = (lane == nts) ? (int)(unsigned)(_c >> 32) : ts_hi; ++nts; } } while (0)
    PG8_STAMP();
    unsigned voffA[2], voffB[2];
#pragma unroll
    for (int i = 0; i < 2; ++i) { int R, C; stage_rc(tid * 16 + i * 8192, R, C); const int Rb = Epi::PERM ? ((R & ~31) + perm32(R & 31)) : R;
        voffA[i] = (unsigned)(R * LD + C) * 2u; voffB[i] = (unsigned)(Rb * LD + C) * 2u; }
    const size_t kstep = (size_t)(BK * 2);
    const size_t hstep = (size_t)HALF * LD * 2;
    const size_t tstep = 2 * hstep;
    const unsigned ldsw = (unsigned)wid * 1024u;
    const int aoff = lds_byte(wr * 64 + fr, fq * 8), boff = lds_byte(wc * 32 + fr, fq * 8);
#define PG8_SA(b, h) (((b) * 2 + (h)) * HTB)
#define PG8_SB(b, h) ((4 + (b) * 2 + (h)) * HTB)
#define PG8_STAGE(bufoff, gbase, voff) do { _Pragma("unroll") for (int _i = 0; _i < 2; ++_i) \
        __builtin_amdgcn_global_load_lds((const unsigned*)((const char*)(gbase) + (voff)[_i]), (PG8_LAS unsigned*)(lds + (bufoff) + ldsw + _i * 8192), 16, 0, 0); } while (0)
#define PG8_LDA(dst, b, h) do { _Pragma("unroll") for (int m = 0; m < 4; ++m) _Pragma("unroll") for (int k = 0; k < 2; ++k) dst[m][k] = *(const PG8_LAS bf16x8*)(lds + PG8_SA(b, h) + aoff + m * 2048 + k * 1024); } while (0)
#define PG8_LDB(dst, b, h) do { _Pragma("unroll") for (int n = 0; n < 2; ++n) _Pragma("unroll") for (int k = 0; k < 2; ++k) dst[n][k] = *(const PG8_LAS bf16x8*)(lds + PG8_SB(b, h) + boff + n * 2048 + k * 1024); } while (0)
#define PG8_MMA(ai, bj, At, Bt) do { __builtin_amdgcn_s_setprio(1); _Pragma("unroll") for (int m = 0; m < 4; ++m) _Pragma("unroll") for (int n = 0; n < 2; ++n) _Pragma("unroll") for (int k = 0; k < 2; ++k) \
        acc[ai][bj][m][n] = __builtin_amdgcn_mfma_f32_16x16x32_bf16(Bt[n][k], At[m][k], acc[ai][bj][m][n], 0, 0, 0); __builtin_amdgcn_s_setprio(0); } while (0)
#define PG8_WAIT_V(n) asm volatile("s_waitcnt vmcnt(" #n ")" ::: "memory")
#define PG8_WAIT_L(n) asm volatile("s_waitcnt lgkmcnt(" #n ")" ::: "memory")
#define PG8_BAR __builtin_amdgcn_s_barrier()
#define PG8_SCHED __builtin_amdgcn_sched_barrier(0)
    Unit cur, nxt; int ui = 0;
    if (!S.next(0, cur)) return;
    f32x4 acc[2][2][4][2];
#pragma unroll
    for (int a = 0; a < 2; ++a)
#pragma unroll
        for (int b = 0; b < 2; ++b)
#pragma unroll
            for (int m = 0; m < 4; ++m)
#pragma unroll
                for (int n = 0; n < 2; ++n) acc[a][b][m][n] = (f32x4){0.f, 0.f, 0.f, 0.f};
    bf16x8 At[4][2], B0[2][2], B1[2][2];
    const char* cA = (const char*)g.A + (size_t)cur.pm * tstep; const char* cB = (const char*)g.Bt + (size_t)cur.pn * tstep;
    S.a_ready(cur);
    PG8_STAGE(PG8_SB(0, 0), cB, voffB); PG8_STAGE(PG8_SA(0, 0), cA, voffA); PG8_STAGE(PG8_SB(0, 1), cB + hstep, voffB); PG8_STAGE(PG8_SA(0, 1), cA + hstep, voffA);
    if (wr == 1) PG8_BAR;
    PG8_WAIT_V(4); PG8_BAR;
    PG8_STAGE(PG8_SB(1, 0), cB + kstep, voffB); PG8_STAGE(PG8_SA(1, 0), cA + kstep, voffA); PG8_STAGE(PG8_SB(1, 1), cB + hstep + kstep, voffB);
    PG8_WAIT_V(6); PG8_BAR;
    PG8_STAMP();
    for (;;) {
        const bool has_next = S.next(ui + 1, nxt);
        const char* nA = has_next ? (const char*)g.A + (size_t)nxt.pm * tstep : cA; const char* nB = has_next ? (const char*)g.Bt + (size_t)nxt.pn * tstep : cB;
        for (int t = 0; t < nt; t += 2) {
            const bool last = (t == nt - 2);
            const char* a1 = cA + (size_t)(t + 1) * kstep;
            const char* a2 = last ? nA : cA + (size_t)(t + 2) * kstep; const char* b2 = last ? nB : cB + (size_t)(t + 2) * kstep;
            const char* a3 = a2 + kstep; const char* b3 = b2 + kstep;
            if (last && has_next) S.a_ready(nxt);
            PG8_LDB(B0, 0, 0); PG8_SCHED; PG8_LDA(At, 0, 0); PG8_STAGE(PG8_SA(1, 1), a1 + hstep, voffA);
            PG8_WAIT_L(8); PG8_BAR; PG8_WAIT_L(0); PG8_MMA(0, 0, At, B0); PG8_BAR; PG8_SCHED;
            PG8_LDB(B1, 0, 1); PG8_STAGE(PG8_SB(0, 0), b2, voffB);
            PG8_BAR; PG8_WAIT_L(0); PG8_MMA(0, 1, At, B1); PG8_BAR;
            PG8_LDA(At, 0, 1); PG8_STAGE(PG8_SA(0, 0), a2, voffA);
            PG8_BAR; PG8_WAIT_L(0); PG8_MMA(1, 0, At, B0); PG8_BAR; PG8_SCHED;
            PG8_STAGE(PG8_SB(0, 1), b2 + hstep, voffB);
            PG8_WAIT_V(6); PG8_BAR; PG8_MMA(1, 1, At, B1); PG8_BAR;
            PG8_LDB(B0, 1, 0); PG8_SCHED; PG8_LDA(At, 1, 0); PG8_STAGE(PG8_SA(0, 1), a2 + hstep, voffA);
            PG8_WAIT_L(8); PG8_BAR; PG8_WAIT_L(0); PG8_MMA(0, 0, At, B0); PG8_BAR; PG8_SCHED;
            PG8_LDB(B1, 1, 1); PG8_STAGE(PG8_SB(1, 0), b3, voffB);
            PG8_BAR; PG8_WAIT_L(0); PG8_MMA(0, 1, At, B1); PG8_BAR;
            PG8_LDA(At, 1, 1); PG8_STAGE(PG8_SA(1, 0), a3, voffA);
            PG8_BAR; PG8_WAIT_L(0); PG8_MMA(1, 0, At, B0); PG8_BAR; PG8_SCHED;
            PG8_STAGE(PG8_SB(1, 1), b3 + hstep, voffB);
            PG8_WAIT_V(6); PG8_BAR; PG8_MMA(1, 1, At, B1); PG8_BAR;
        }
        PG8_STAMP();
        if constexpr (!Epi::AFTER_DRAIN) { E(acc, cur, wr, wc, fr, fq); S.done(cur); }
        PG8_STAMP();
        if (!has_next) break;
#pragma unroll
        for (int a = 0; a < 2; ++a)
#pragma unroll
            for (int b = 0; b < 2; ++b)
#pragma unroll
                for (int m = 0; m < 4; ++m)
#pragma unroll
                    for (int n = 0; n < 2; ++n) acc[a][b][m][n] = (f32x4){0.f, 0.f, 0.f, 0.f};
        cur = nxt; cA = nA; cB = nB; ++ui;
    }
    PG8_WAIT_V(0);
    if (wr == 0) PG8_BAR;
    PG8_BAR;
    if constexpr (Epi::AFTER_DRAIN) { E.fused(acc, cur, wr, wc, fr, fq, lds, wid, lane); S.done(cur); }
    PG8_STAMP();
    if (STAMP && wid == 0) { stamps[lane] = lane < nts ? (((unsigned long long)(unsigned)ts_hi << 32) | (unsigned)ts_lo) : 0ull;
        if (lane == 62) stamps[62] = rt_entry; if (lane == 63) stamps[63] = (unsigned long long)wall_clock64(); }
#undef PG8_STAMP
#undef PG8_SA
#undef PG8_SB
#undef PG8_STAGE
#undef PG8_LDA
#undef PG8_LDB
#undef PG8_MMA
#undef PG8_WAIT_V
#undef PG8_WAIT_L
#undef PG8_BAR
#undef PG8_SCHED
}
}
using namespace pg8;
typedef short s16x4 __attribute__((ext_vector_type(4)));
typedef unsigned u32x2 __attribute__((ext_vector_type(2)));
#define LAS PG8_LAS

struct RangeOrder : StaticOrder {
    int imax;
    __device__ __forceinline__ bool next(int i, Unit& u) const { if (i >= imax) return false; return StaticOrder::next(i, u); }
};
struct OneUnit {
    Unit u0;
    __device__ __forceinline__ bool next(int i, Unit& u) const { if (i) return false; u = u0; return true; }
    __device__ __forceinline__ void a_ready(const Unit&) const {}
    __device__ __forceinline__ void done(const Unit&) const {}
};
template <bool PERM_> struct EpiSlab {
    static constexpr bool PERM = PERM_, AFTER_DRAIN = false;
    float* slab;
    __device__ __forceinline__ void operator()(const f32x4 (&acc)[2][2][4][2], const Unit&, int, int, int, int) const {
        unsigned long long* sp = (unsigned long long*)slab + threadIdx.x;
#pragma unroll
        for (int ai = 0; ai < 2; ++ai)
#pragma unroll
            for (int m = 0; m < 4; ++m)
#pragma unroll
                for (int bj = 0; bj < 2; ++bj)
#pragma unroll
                    for (int n = 0; n < 2; ++n) { const f32x4 v = acc[ai][bj][m][n]; const int idx = (((ai * 4 + m) * 2 + bj) * 2 + n) * 2;
                        __hip_atomic_store(sp + (size_t)idx * 512, ((unsigned long long)__float_as_uint(v[1]) << 32) | __float_as_uint(v[0]), __ATOMIC_RELAXED, __HIP_MEMORY_SCOPE_AGENT);
                        __hip_atomic_store(sp + (size_t)(idx + 1) * 512, ((unsigned long long)__float_as_uint(v[3]) << 32) | __float_as_uint(v[2]), __ATOMIC_RELAXED, __HIP_MEMORY_SCOPE_AGENT); }
    }
};
#define XB_TMO      128
#define XB_XCNT(j)  (256  + 64 * (j))
#define XB_XSUB(j)  (1280 + 64 * (j))
#define XB_XGEN(j)  (2304 + 64 * (j))
#define XB_TOP      3328
#define XB_TOPGEN   3392
#define XCD_BAR_WORDS 3456
#define XB_SPIN_CAP (1u << 18)

__device__ __forceinline__ unsigned xb_ld(unsigned* p)              { return __hip_atomic_load(p, __ATOMIC_RELAXED, __HIP_MEMORY_SCOPE_AGENT); }
__device__ __forceinline__ unsigned xb_add(unsigned* p, unsigned v) { return __hip_atomic_fetch_add(p, v, __ATOMIC_RELAXED, __HIP_MEMORY_SCOPE_AGENT); }
__device__ __forceinline__ unsigned xb_xcc_id() { return (unsigned)__builtin_amdgcn_s_getreg((3 << 11) | 20) & 0xFu; }
#define XB_SPIN(cond, bar) do { unsigned _sp = 0; while (cond) { __builtin_amdgcn_s_sleep(1); \
    if ((++_sp & 255u) == 0u) { if (xb_ld(&(bar)[XB_TMO])) break; if (_sp > XB_SPIN_CAP) { atomicAdd(&(bar)[XB_TMO], 1u); break; } } } } while (0)

struct XcdBarrier {
    unsigned* bar; unsigned x;
    volatile LAS unsigned* st;
};

__device__ __forceinline__ XcdBarrier xcd_barrier_post(unsigned* bar, volatile LAS unsigned* st) {
    XcdBarrier b; b.bar = bar; b.x = xb_xcc_id(); b.st = st;
    if (threadIdx.x == 0) (void)xb_add(&bar[XB_XCNT(b.x)], 1u);
    return b;
}
__device__ __forceinline__ void xcd_barrier_complete(unsigned* bar, unsigned x, unsigned& nloc, unsigned& nx) {
    const unsigned G = gridDim.x * gridDim.y * gridDim.z;
    unsigned sum, cnt, mine, sp = 0u;
    for (;;) {
        sum = 0u; cnt = 0u; mine = 0u;
#pragma unroll
        for (unsigned j = 0; j < 16; ++j) { const unsigned c = xb_ld(&bar[XB_XCNT(j)]); sum += c; cnt += (c > 0u) ? 1u : 0u; mine = (j == x) ? c : mine; }
        if (sum == G) break;
        __builtin_amdgcn_s_sleep(1);
        if ((++sp & 255u) == 0u) { if (xb_ld(&bar[XB_TMO])) break; if (sp > XB_SPIN_CAP) { atomicAdd(&bar[XB_TMO], 1u); break; } }
    }
    nloc = mine > 0u ? mine : 1u; nx = cnt > 0u ? cnt : 1u;
}

__device__ __forceinline__ void xcd_barrier(const XcdBarrier& b) {
    asm volatile("s_waitcnt vmcnt(0)" ::: "memory");
    __syncthreads();
    if (threadIdx.x == 0) {
        unsigned* bar = b.bar;
        __builtin_amdgcn_s_waitcnt(0);
        unsigned nloc = b.st[0], nx = b.st[1];
        if (nloc == 0u) { xcd_barrier_complete(bar, b.x, nloc, nx); b.st[0] = nloc; b.st[1] = nx; }
        const unsigned old = xb_add(&bar[XB_XSUB(b.x)], 1u);
        const unsigned gen = old / nloc;
        if (old + 1u == (gen + 1u) * nloc) {
            __builtin_amdgcn_fence(__ATOMIC_RELEASE, "agent");
            asm volatile("s_waitcnt vmcnt(0)" ::: "memory");
            const unsigned og = xb_add(&bar[XB_TOP], 1u);
            const unsigned tg = og / nx;
            if (og + 1u == (tg + 1u) * nx) xb_add(&bar[XB_TOPGEN], 1u);
            else XB_SPIN(xb_ld(&bar[XB_TOPGEN]) == tg, bar);
            __builtin_amdgcn_fence(__ATOMIC_ACQUIRE, "agent");
            xb_add(&bar[XB_XGEN(b.x)], 1u);
            asm volatile("s_waitcnt vmcnt(0)" ::: "memory");
        } else {
            XB_SPIN(xb_ld(&bar[XB_XGEN(b.x)]) == gen, bar);
            __builtin_amdgcn_fence(__ATOMIC_ACQUIRE, "agent");
            asm volatile("s_waitcnt vmcnt(0)" ::: "memory");
        }
    }
    __syncthreads();
}

constexpr int NTOK = 18432, NP = 16384, DM = 1024, DV = 2048, DFF = 2816;
constexpr float ALPHA = 1.189207115002721f;
constexpr size_t WS_XB = 0;
constexpr size_t WS_WIN = WS_XB + (size_t)NTOK * DM * 2;
constexpr size_t WS_WR = WS_WIN + (size_t)11264 * 1024 * 2;
constexpr size_t WS_WC = WS_WR + (size_t)1024 * 2048 * 2;
constexpr size_t WS_WO = WS_WC + (size_t)1024 * 1024 * 2;
constexpr size_t WS_WUP = WS_WO + (size_t)1024 * 1024 * 2;
constexpr size_t WS_WD = WS_WUP + (size_t)5632 * 1024 * 2;
constexpr size_t WS_ROPE = WS_WD + (size_t)1024 * 2816 * 2;
constexpr size_t WS_SSQ = WS_ROPE + (size_t)2112 * 256 * 4;
constexpr size_t WS_Q = WS_SSQ + (size_t)NTOK * 128 * 4;
constexpr size_t WS_K = WS_Q + (size_t)NTOK * DM * 2;
constexpr size_t WS_V = WS_K + (size_t)NTOK * DM * 2;
constexpr size_t WS_BAR = WS_V + (size_t)NTOK * DV * 2;
constexpr int TAIL_CNT_WORDS = 2560;
constexpr size_t WS_CSLAB = WS_BAR + (size_t)(XCD_BAR_WORDS + TAIL_CNT_WORDS) * 4;
constexpr size_t WS_END = WS_CSLAB + ((size_t)16 << 20);
constexpr size_t OUT_SP = 18874368, OUT_CP = 23068672, OUT_SS = 23085056, OUT_CS = 39862272;

struct Params {
    const float *x_prompt, *x_sample, *state_ret, *cache_conv, *w_in, *w_conv, *w_ret_out, *w_conv_out, *w_o, *ln1_g, *ln1_b, *w_up, *w_down, *ln2_g, *ln2_b;
    float* out; unsigned char* ws; int ph_lo, ph_hi;
};

__device__ __forceinline__ float lg2g(int h) { return h == 0 ? -0.045803689613125f : (h == 1 ? -0.022720076500083f : (h == 2 ? -0.011315313227834f : -0.005646563141142f)); }
__device__ __forceinline__ float fsigmoid(float x) { return __builtin_amdgcn_rcpf(1.0f + __builtin_amdgcn_exp2f(-1.4426950408889634f * x)); }
__device__ __forceinline__ float fsilu(float x) { return x * __builtin_amdgcn_rcpf(1.0f + __builtin_amdgcn_exp2f(-1.4426950408889634f * x)); }
__device__ __forceinline__ float bf2f(unsigned short b) { return __uint_as_float(((unsigned)b) << 16); }
__device__ __forceinline__ float bflo(unsigned w) { return __uint_as_float(w << 16); }
__device__ __forceinline__ float bfhi(unsigned w) { return __uint_as_float(w & 0xffff0000u); }
__device__ __forceinline__ u32x4 pack8(f32x4 a, f32x4 b) { u32x4 w; w.x = cvt_pk_bf16(a[0], a[1]); w.y = cvt_pk_bf16(a[2], a[3]); w.z = cvt_pk_bf16(b[0], b[1]); w.w = cvt_pk_bf16(b[2], b[3]); return w; }
__device__ __forceinline__ void unpack8(u32x4 w, f32x4& a, f32x4& b) { a = (f32x4){bflo(w.x), bfhi(w.x), bflo(w.y), bfhi(w.y)}; b = (f32x4){bflo(w.z), bfhi(w.z), bflo(w.w), bfhi(w.w)}; }

__device__ __forceinline__ int win_col(int nb) {
    const int n = nb * 64;
    if (n < 6144) return n;
    if (n < 10240) { const int w = n - 6144, j = w >> 8, seg = (w >> 6) & 3; const int base = seg == 0 ? 7168 : (seg == 1 ? 6144 : (seg == 2 ? 8192 : 10240)); return base + 64 * j; }
    return 9216 + (n - 10240);
}
__device__ __forceinline__ int wup_col(int nb) { const int pn = nb >> 2, sub = nb & 3; return sub < 2 ? 128 * pn + 64 * sub : 2816 + 128 * pn + 64 * (sub - 2); }

__device__ __forceinline__ void transpose_tile(const float* src, int ld, int k0, int c0, bf16_t* dst, int K, int n0, LAS float* t) {
    const int tid = threadIdx.x;
#pragma unroll
    for (int it = 0; it < 2; ++it) { const int idx = tid + it * 512, kr = idx >> 4, c4 = idx & 15;
        const f32x4 v = __builtin_nontemporal_load((const f32x4*)(src + (size_t)(k0 + kr) * ld + c0 + c4 * 4));
        t[kr * 65 + c4 * 4 + 0] = v[0]; t[kr * 65 + c4 * 4 + 1] = v[1]; t[kr * 65 + c4 * 4 + 2] = v[2]; t[kr * 65 + c4 * 4 + 3] = v[3]; }
    __syncthreads();
    const int n = tid >> 3, kg = tid & 7;
    float f[8];
#pragma unroll
    for (int i = 0; i < 8; ++i) f[i] = t[(kg * 8 + i) * 65 + n];
    u32x4 w; w.x = cvt_pk_bf16(f[0], f[1]); w.y = cvt_pk_bf16(f[2], f[3]); w.z = cvt_pk_bf16(f[4], f[5]); w.w = cvt_pk_bf16(f[6], f[7]);
    *(u32x4*)(dst + (size_t)(n0 + n) * K + k0 + kg * 8) = w;
    __syncthreads();
}

__device__ __forceinline__ void phase_convert(const Params& p, LAS unsigned char* lds, int part) {
    if (part == 0) {
    const size_t gtid = (size_t)blockIdx.x * 512 + threadIdx.x, gsz = (size_t)gridDim.x * 512;
    bf16_t* xb = (bf16_t*)(p.ws + WS_XB);
    for (size_t i = gtid; i < (size_t)NTOK * DM / 8; i += gsz) {
        const size_t e = i * 8; const float* src = e < (size_t)NP * DM ? p.x_prompt + e : p.x_sample + (e - (size_t)NP * DM);
        const f32x4 a = __builtin_nontemporal_load((const f32x4*)src), b = __builtin_nontemporal_load((const f32x4*)(src + 4));
        *(u32x4*)(xb + e) = pack8(a, b);
    }
    float* rope = (float*)(p.ws + WS_ROPE);
    for (size_t i = gtid; i < (size_t)2112 * 128; i += gsz) {
        const int pos = (int)(i >> 7), f = (int)(i & 127);
        const float lin = (float)f * (1.0f / 127.0f);
        const float inv = 1.0f / exp2f(lin * 13.287712379549449f);
        const float ang = (float)pos * inv;
        const double a = (double)ang; const double n = rint(a * 0.15915494309189535); const float r = (float)(a - n * 6.283185307179586);
        rope[(size_t)pos * 256 + f] = __cosf(r); rope[(size_t)pos * 256 + 128 + f] = __sinf(r);
    }
    }
    LAS float* t = (LAS float*)lds;
    constexpr int T_IN = 16 * 176, T_R = 32 * 16, T_C = 16 * 16, T_O = 16 * 16, T_UP = 16 * 88, T_D = 44 * 16;
    constexpr int TT = T_IN + T_R + T_C + T_O + T_UP + T_D;
    const int lo = part == 0 ? 0 : (part == 1 ? 1024 : (part == 2 ? 3584 : 4544)), hi = part == 0 ? 1792 : (part == 1 ? 2816 : (part == 2 ? 4544 : 5952));
    const int w0 = part == 0 ? (int)blockIdx.x : (part == 2 ? (int)blockIdx.x - 192 : (int)blockIdx.x - 128), wstep = part == 0 ? (int)gridDim.x : (part == 2 ? 64 : 128);
    for (int wi = lo + w0; wi < hi; wi += wstep) {
        const int ti = part == 0 ? (wi < 1024 ? wi : wi + 1792) : wi;
        int x = ti;
        if (x < T_IN) { const int nb = x >> 4, kb = x & 15; transpose_tile(p.w_in, 11264, kb * 64, win_col(nb), (bf16_t*)(p.ws + WS_WIN), 1024, nb * 64, t); continue; } x -= T_IN;
        if (x < T_R) { const int nb = x >> 5, kb = x & 31; transpose_tile(p.w_ret_out, 1024, kb * 64, nb * 64, (bf16_t*)(p.ws + WS_WR), 2048, nb * 64, t); continue; } x -= T_R;
        if (x < T_C) { const int nb = x >> 4, kb = x & 15; transpose_tile(p.w_conv_out, 1024, kb * 64, nb * 64, (bf16_t*)(p.ws + WS_WC), 1024, nb * 64, t); continue; } x -= T_C;
        if (x < T_O) { const int nb = x >> 4, kb = x & 15; transpose_tile(p.w_o, 1024, kb * 64, nb * 64, (bf16_t*)(p.ws + WS_WO), 1024, nb * 64, t); continue; } x -= T_O;
        if (x < T_UP) { const int nb = x >> 4, kb = x & 15; transpose_tile(p.w_up, 5632, kb * 64, wup_col(nb), (bf16_t*)(p.ws + WS_WUP), 1024, nb * 64, t); continue; } x -= T_UP;
        { const int nb = x / 44, kb = x % 44; transpose_tile(p.w_down, 1024, kb * 64, nb * 64, (bf16_t*)(p.ws + WS_WD), 2816, nb * 64, t); }
    }
}

__device__ __forceinline__ int row_pos(int r) { return r < NP ? (r & 2047) : 2048 + ((r - NP) & 63); }

struct Epi1a {
    static constexpr bool PERM = true, AFTER_DRAIN = false;
    bf16_t *qb, *kb, *vb; const float* rope;
    __device__ __forceinline__ void operator()(const f32x4 (&acc)[2][2][4][2], const Unit& u, int wr, int wc, int fr, int fq) const {
        const int row0 = u.pm * BM + wr * 64 + fr;
        if (u.pn < 8) {
            const bool isq = u.pn < 4; const int h = u.pn & 3; const float lg = lg2g(h);
            bf16_t* base = (isq ? qb : kb) + h * 256;
            const int d0 = wc * 32 + 8 * fq;
#pragma unroll
            for (int ai = 0; ai < 2; ++ai)
#pragma unroll
                for (int m = 0; m < 4; ++m) {
                    const int r = row0 + ai * HALF + m * 16;
                    const float sc = isq ? __builtin_amdgcn_exp2f(lg * (float)((r & 63) + 1)) : 0.0625f;
                    const float* tc = rope + (size_t)row_pos(r) * 256 + d0;
                    const f32x4 c0 = *(const f32x4*)tc, c1 = *(const f32x4*)(tc + 4), s0 = *(const f32x4*)(tc + 128), s1 = *(const f32x4*)(tc + 132);
                    const f32x4 x1a = acc[ai][0][m][0], x1b = acc[ai][0][m][1], x2a = acc[ai][1][m][0], x2b = acc[ai][1][m][1];
                    const f32x4 o1a = (x1a * c0 - x2a * s0) * sc, o1b = (x1b * c1 - x2b * s1) * sc;
                    const f32x4 o2a = (x1a * s0 + x2a * c0) * sc, o2b = (x1b * s1 + x2b * c1) * sc;
                    bf16_t* rp = base + (size_t)r * 1024 + d0;
                    *(u32x4*)rp = pack8(o1a, o1b); *(u32x4*)(rp + 128) = pack8(o2a, o2b);
                    asm volatile("" ::: "memory");
                }
        } else {
            const int cv = (u.pn - 8) * 256, h = cv >> 9; const float lg = lg2g(h);
#pragma unroll
            for (int ai = 0; ai < 2; ++ai)
#pragma unroll
                for (int m = 0; m < 4; ++m) {
                    const int r = row0 + ai * HALF + m * 16;
                    const float sc = __builtin_amdgcn_exp2f(lg * (float)(63 - (r & 63)));
                    bf16_t* rp = vb + (size_t)r * 2048 + cv + wc * 32 + 8 * fq;
#pragma unroll
                    for (int bj = 0; bj < 2; ++bj) *(u32x4*)(rp + bj * HALF) = pack8(acc[ai][bj][m][0] * sc, acc[ai][bj][m][1] * sc);
                }
        }
    }
};

struct Epi1b {
    static constexpr bool PERM = true, AFTER_DRAIN = false;
    bf16_t *ob, *cbb, *ub, *sgrb, *sgcb; const float* ssq; float* out;
    __device__ __forceinline__ void operator()(const f32x4 (&acc)[2][2][4][2], const Unit& u, int wr, int wc, int fr, int fq) const {
        const int row0 = u.pm * BM + wr * 64 + fr;
        if (u.pn < 8) {
            const int h = u.pn >> 1, col = u.pn * 256 + wc * 32 + 8 * fq;
#pragma unroll
            for (int ai = 0; ai < 2; ++ai) {
                u32x4 ov[4][2]; f32x4 t4[4];
#pragma unroll
                for (int m = 0; m < 4; ++m) {
                    const int r = row0 + ai * HALF + m * 16;
                    const f32x4* sp = (const f32x4*)(ssq + (size_t)r * 128 + h * 32);
                    t4[m] = ((sp[0] + sp[1]) + (sp[2] + sp[3])) + ((sp[4] + sp[5]) + (sp[6] + sp[7]));
                    const bf16_t* rp = ob + (size_t)r * 2048 + col;
                    ov[m][0] = *(const u32x4*)rp; ov[m][1] = *(const u32x4*)(rp + HALF);
                }
#pragma unroll
                for (int m = 0; m < 4; ++m) {
                    const int r = row0 + ai * HALF + m * 16;
                    const float rstd = rsqrtf(((t4[m][0] + t4[m][1]) + (t4[m][2] + t4[m][3])) * (1.0f / 512.0f) + 1e-6f);
                    bf16_t* rp = ob + (size_t)r * 2048 + col;
#pragma unroll
                    for (int bj = 0; bj < 2; ++bj) {
                        f32x4 oa, obv; unpack8(ov[m][bj], oa, obv);
                        f32x4 ga = acc[ai][bj][m][0], gb = acc[ai][bj][m][1];
#pragma unroll
                        for (int j = 0; j < 4; ++j) { ga[j] = fsilu(ga[j]) * oa[j] * rstd; gb[j] = fsilu(gb[j]) * obv[j] * rstd; }
                        *(u32x4*)(rp + bj * HALF) = pack8(ga, gb);
                    }
                }
            }
        } else if (u.pn < 24) {
            const int j64 = (u.pn - 8) * 64;
            if (wc < 2) {
                const int col = j64 + wc * 32 + 8 * fq;
#pragma unroll
                for (int ai = 0; ai < 2; ++ai)
#pragma unroll
                    for (int m = 0; m < 4; ++m) {
                        const int r = row0 + ai * HALF + m * 16;
                        const f32x4 ua = acc[ai][0][m][0] * acc[ai][1][m][0], uv = acc[ai][0][m][1] * acc[ai][1][m][1];
                        *(u32x4*)(ub + (size_t)r * 1024 + col) = pack8(ua, uv);
                        if (r < NP) { const int pos = r & 2047; if (pos >= 2046) { float* cp = out + OUT_CP + ((size_t)(r >> 11) * 2 + (pos - 2046)) * 1024 + col; *(f32x4*)cp = ua; *(f32x4*)(cp + 4) = uv; } }
                        else { const int s = r - NP, pos = s & 63; if (pos >= 62) { float* cp = out + OUT_CS + ((size_t)(s >> 6) * 2 + (pos - 62)) * 1024 + col; *(f32x4*)cp = ua; *(f32x4*)(cp + 4) = uv; } }
                    }
            } else {
                const int col = j64 + (wc - 2) * 32 + 8 * fq;
#pragma unroll
                for (int ai = 0; ai < 2; ++ai)
#pragma unroll
                    for (int m = 0; m < 4; ++m) {
                        const int r = row0 + ai * HALF + m * 16;
                        *(u32x4*)(cbb + (size_t)r * 1024 + col) = pack8(acc[ai][0][m][0], acc[ai][0][m][1]);
                        f32x4 ga = acc[ai][1][m][0], gb = acc[ai][1][m][1];
#pragma unroll
                        for (int j = 0; j < 4; ++j) { ga[j] = fsigmoid(ga[j]); gb[j] = fsigmoid(gb[j]); }
                        *(u32x4*)(sgcb + (size_t)r * 1024 + col) = pack8(ga, gb);
                    }
            }
        } else {
            const int col = (u.pn - 24) * 256 + wc * 32 + 8 * fq;
#pragma unroll
            for (int ai = 0; ai < 2; ++ai)
#pragma unroll
                for (int m = 0; m < 4; ++m) {
                    const int r = row0 + ai * HALF + m * 16;
#pragma unroll
                    for (int bj = 0; bj < 2; ++bj) {
                        f32x4 ga = acc[ai][bj][m][0], gb = acc[ai][bj][m][1];
#pragma unroll
                        for (int j = 0; j < 4; ++j) { ga[j] = fsigmoid(ga[j]); gb[j] = fsigmoid(gb[j]); }
                        *(u32x4*)(sgrb + (size_t)r * 1024 + col + bj * HALF) = pack8(ga, gb);
                    }
                }
        }
    }
};

template <int SECOND> struct EpiMerge {
    static constexpr bool PERM = true, AFTER_DRAIN = false;
    bf16_t* mb; const bf16_t* gate; unsigned selmask;
    __device__ __forceinline__ void operator()(const f32x4 (&acc)[2][2][4][2], const Unit& u, int wr, int wc, int fr, int fq) const {
        const int row0 = u.pm * BM + wr * 64 + fr, col = u.pn * BM + wc * 32 + 8 * fq;
#pragma unroll
        for (int ai = 0; ai < 2; ++ai) {
            u32x4 gv[4][2], pv[4][2];
#pragma unroll
            for (int m = 0; m < 4; ++m) {
                if (!((selmask >> (ai * 4 + m)) & 1u)) continue;
                const size_t off = (size_t)(row0 + ai * HALF + m * 16) * 1024 + col;
#pragma unroll
                for (int bj = 0; bj < 2; ++bj) { gv[m][bj] = *(const u32x4*)(gate + off + bj * HALF); if (SECOND) pv[m][bj] = *(const u32x4*)(mb + off + bj * HALF); }
            }
#pragma unroll
            for (int m = 0; m < 4; ++m) {
                if (!((selmask >> (ai * 4 + m)) & 1u)) continue;
                const size_t off = (size_t)(row0 + ai * HALF + m * 16) * 1024 + col;
#pragma unroll
                for (int bj = 0; bj < 2; ++bj) {
                    f32x4 ga, gb; unpack8(gv[m][bj], ga, gb);
                    f32x4 va = acc[ai][bj][m][0] * ga, vb = acc[ai][bj][m][1] * gb;
                    if (SECOND) { f32x4 pa, pb; unpack8(pv[m][bj], pa, pb); va += pa; vb += pb; }
                    *(u32x4*)(mb + off + bj * HALF) = pack8(va, vb);
                }
            }
        }
    }
};

struct EpiRes {
    static constexpr bool PERM = false, AFTER_DRAIN = false;
    const float* base_p; const float* base_s; float* o; unsigned selmask;
    __device__ __forceinline__ void operator()(const f32x4 (&acc)[2][2][4][2], const Unit& u, int wr, int wc, int fr, int fq) const {
        const int row0 = u.pm * BM + wr * 64 + fr, col0 = u.pn * BM + wc * 32 + 4 * fq;
#pragma unroll
        for (int ai = 0; ai < 2; ++ai)
#pragma unroll
            for (int mp = 0; mp < 2; ++mp) {
                f32x4 bs[2][2][2];
#pragma unroll
                for (int mm = 0; mm < 2; ++mm) { const int m = 2 * mp + mm;
                    if (!((selmask >> (ai * 4 + m)) & 1u)) continue;
                    const int r = row0 + ai * HALF + m * 16;
                    const float* bp = (r < NP ? base_p + (size_t)r * 1024 : base_s + (size_t)(r - NP) * 1024) + col0;
#pragma unroll
                    for (int bj = 0; bj < 2; ++bj)
#pragma unroll
                        for (int n = 0; n < 2; ++n) bs[mm][bj][n] = *(const f32x4*)(bp + bj * HALF + n * 16); }
#pragma unroll
                for (int mm = 0; mm < 2; ++mm) { const int m = 2 * mp + mm;
                    if (!((selmask >> (ai * 4 + m)) & 1u)) continue;
                    float* op = o + (size_t)(row0 + ai * HALF + m * 16) * 1024 + col0;
#pragma unroll
                    for (int bj = 0; bj < 2; ++bj)
#pragma unroll
                        for (int n = 0; n < 2; ++n) *(f32x4*)(op + bj * HALF + n * 16) = bs[mm][bj][n] * ALPHA + acc[ai][bj][m][n]; }
            }
    }
};

struct EpiResLn {
    static constexpr bool PERM = false, AFTER_DRAIN = false;
    float* o; const float* g; const float* b; const float* stats; unsigned selmask;
    __device__ __forceinline__ void operator()(const f32x4 (&acc)[2][2][4][2], const Unit& u, int wr, int wc, int fr, int fq) const {
        const int row0 = u.pm * BM + wr * 64 + fr, col0 = u.pn * BM + wc * 32 + 4 * fq;
        f32x4 gv[2][2], bv[2][2];
#pragma unroll
        for (int bj = 0; bj < 2; ++bj)
#pragma unroll
            for (int n = 0; n < 2; ++n) { gv[bj][n] = *(const f32x4*)(g + col0 + bj * HALF + n * 16) * ALPHA; bv[bj][n] = *(const f32x4*)(b + col0 + bj * HALF + n * 16) * ALPHA; }
#pragma unroll
        for (int ai = 0; ai < 2; ++ai)
#pragma unroll
            for (int mp = 0; mp < 2; ++mp) {
                f32x4 hp[2][2][2]; float mu[2], rs[2];
#pragma unroll
                for (int mm = 0; mm < 2; ++mm) { const int m = 2 * mp + mm;
                    if (!((selmask >> (ai * 4 + m)) & 1u)) continue;
                    const int r = row0 + ai * HALF + m * 16;
                    mu[mm] = stats[2 * r]; rs[mm] = stats[2 * r + 1];
                    const float* op = o + (size_t)r * 1024 + col0;
#pragma unroll
                    for (int bj = 0; bj < 2; ++bj)
#pragma unroll
                        for (int n = 0; n < 2; ++n) hp[mm][bj][n] = *(const f32x4*)(op + bj * HALF + n * 16); }
#pragma unroll
                for (int mm = 0; mm < 2; ++mm) { const int m = 2 * mp + mm;
                    if (!((selmask >> (ai * 4 + m)) & 1u)) continue;
                    float* op = o + (size_t)(row0 + ai * HALF + m * 16) * 1024 + col0;
#pragma unroll
                    for (int bj = 0; bj < 2; ++bj)
#pragma unroll
                        for (int n = 0; n < 2; ++n) *(f32x4*)(op + bj * HALF + n * 16) = ((hp[mm][bj][n] - mu[mm]) * rs[mm]) * gv[bj][n] + bv[bj][n] + acc[ai][bj][m][n]; }
            }
    }
};

struct EpiUp {
    static constexpr bool PERM = true, AFTER_DRAIN = false;
    bf16_t* fb;
    __device__ __forceinline__ void operator()(const f32x4 (&acc)[2][2][4][2], const Unit& u, int wr, int wc, int fr, int fq) const {
        const int row0 = u.pm * BM + wr * 64 + fr, col = u.pn * 128 + wc * 32 + 8 * fq;
#pragma unroll
        for (int ai = 0; ai < 2; ++ai)
#pragma unroll
            for (int m = 0; m < 4; ++m) {
                f32x4 va = acc[ai][0][m][0], vb = acc[ai][0][m][1];
#pragma unroll
                for (int j = 0; j < 4; ++j) { va[j] = fsilu(va[j]) * acc[ai][1][m][0][j]; vb[j] = fsilu(vb[j]) * acc[ai][1][m][1][j]; }
                *(u32x4*)(fb + (size_t)(row0 + ai * HALF + m * 16) * DFF + col) = pack8(va, vb);
            }
    }
};

__device__ __forceinline__ bf16x8 mk8(s16x4 lo, s16x4 hi) { return __builtin_shufflevector(lo, hi, 0, 1, 2, 3, 4, 5, 6, 7); }
__device__ __forceinline__ int offQK(int row, int cb) { return row * 576 + (cb ^ (((row >> 3) & 1) << 5)); }
__device__ __forceinline__ int offV(int row, int cb) { return row * 192 + (cb ^ (((row >> 3) & 1) << 5)); }
__device__ __forceinline__ int offS(int row, int cb) { return row * 192 + (cb ^ (((row >> 1) & 7) << 3)); }
template <int IMG> __device__ __forceinline__ bf16x8 trfrag(LAS unsigned char* img, int krow0, int col0, int lane) {
    const int g = lane >> 4, q = (lane & 15) >> 2, pp = lane & 3, row = krow0 + 8 * g + q, cb = (col0 + 4 * pp) * 2;
    const int a0 = IMG == 0 ? offQK(row, cb) : (IMG == 1 ? offV(row, cb) : offS(row, cb));
    const int a1 = IMG == 0 ? offQK(row + 4, cb) : (IMG == 1 ? offV(row + 4, cb) : offS(row + 4, cb));
    const s16x4 lo = __builtin_amdgcn_ds_read_tr16_b64_v4i16((LAS s16x4*)(img + a0));
    const s16x4 hi = __builtin_amdgcn_ds_read_tr16_b64_v4i16((LAS s16x4*)(img + a1));
    return mk8(lo, hi);
}
#define MFMA16(a, b, c) __builtin_amdgcn_mfma_f32_16x16x32_bf16((a), (b), (c), 0, 0, 0)

#define LDS_BARRIER() do { asm volatile("s_waitcnt lgkmcnt(0)" ::: "memory"); __builtin_amdgcn_s_barrier(); asm volatile("" ::: "memory"); } while (0)
struct RItem { int h, es; size_t row0; const float* S0; float* Sout; };
__device__ __forceinline__ RItem ret_prompt_item(const Params& p, int item) {
    const int xcd = item & 7, idx = item >> 3, bh = xcd * 4 + (idx >> 3), es = idx & 7, b = bh >> 2, h = bh & 3;
    return RItem{h, es, (size_t)b * 2048, nullptr, p.out + OUT_SP + ((size_t)(b * 4 + h) * 256) * 512 + es * 64};
}
__device__ __forceinline__ RItem ret_sample_item(const Params& p, int s) {
    const int xcd = s & 7, idx = s >> 3, bh = xcd * 16 + (idx >> 3), es = idx & 7, b = bh >> 2, h = bh & 3;
    return RItem{h, es, (size_t)NP + (size_t)b * 64, p.state_ret + ((size_t)(b * 4 + h) * 256) * 512 + es * 64, p.out + OUT_SS + ((size_t)(b * 4 + h) * 256) * 512 + es * 64};
}
__device__ __forceinline__ void phase_retention(const Params& p, LAS unsigned char* lds) {
    int tid_ = threadIdx.x; asm volatile("" : "+v"(tid_));
    const int tid = tid_, wid = __builtin_amdgcn_readfirstlane(tid >> 6), lane = tid & 63, fr = lane & 15, fq = lane >> 4, q4 = (lane & 15) >> 2, pp = lane & 3;
    constexpr int OFF_Q = 0, OFF_K = 36864, OFF_V = 73728, OFF_P = 86016, OFF_S = 96256;
    const bf16_t* qb = (const bf16_t*)(p.ws + WS_Q); const bf16_t* kb = (const bf16_t*)(p.ws + WS_K); const bf16_t* vb = (const bf16_t*)(p.ws + WS_V);
    bf16_t* ob = (bf16_t*)p.out; float* ssq = (float*)(p.ws + WS_SSQ);
    const int lrow = tid >> 3, piece = tid & 7;
    const int ip = wid & 1, hw = wid >> 1;
    const int bid = (int)blockIdx.x;
    const int rQ0 = 32 * ip + fr, rQ1 = rQ0 + 16, rK = 16 * hw + fr, trr = 8 * fq + q4, gb = fq & 1;
    const int aq0 = OFF_Q + rQ0 * 576 + ((fq * 16) ^ (((rQ0 >> 3) & 1) << 5)), aq1 = OFF_Q + rQ1 * 576 + ((fq * 16) ^ (((rQ1 >> 3) & 1) << 5));
    const int ak1 = OFF_K + rK * 576 + ((fq * 16) ^ (((rK >> 3) & 1) << 5));
    const int ap0 = OFF_P + rQ0 * 160 + fq * 16, ap1 = ap0 + 16 * 160;
    const int apw0 = OFF_P + rQ0 * 160 + (16 * hw + 4 * fq) * 2, apw1 = apw0 + 16 * 160;
    const int av2 = OFF_V + trr * 192 + (((16 * hw + 4 * pp) * 2) ^ (gb << 5));
    const int as20 = OFF_S + trr * 192 + (((16 * hw + 4 * pp) * 2) ^ (((trr >> 1) & 7) << 3));
    const int as21 = OFF_S + (trr + 4) * 192 + (((16 * hw + 4 * pp) * 2) ^ ((((trr + 4) >> 1) & 7) << 3));
    const int ak30 = OFF_K + trr * 576 + 64 * wid + 8 * pp + 32 * (0 ^ gb), ak31 = OFF_K + trr * 576 + 64 * wid + 8 * pp + 32 * (1 ^ gb);
    const int av30 = OFF_V + trr * 192 + 8 * pp + 32 * (0 ^ gb), av31 = OFF_V + trr * 192 + 8 * pp + 32 * (1 ^ gb);
    const int swl = ((lrow >> 3) & 1) << 5;
    const int awq = OFF_Q + lrow * 576 + ((piece * 16) ^ swl), awv = OFF_V + lrow * 192 + ((piece * 16) ^ swl);
    const int asw0 = OFF_S + (32 * wid + fr) * 192 + ((8 * fq) ^ (((fr >> 1) & 7) << 3)), asw1 = OFF_S + (32 * wid + fr) * 192 + ((32 + 8 * fq) ^ (((fr >> 1) & 7) << 3));
#define RD128(a) (*(const LAS bf16x8*)(lds + (a)))
#define RDTR(a) __builtin_amdgcn_ds_read_tr16_b64_v4i16((LAS s16x4*)(lds + (a)))
#define RET_LOAD_S(S, src) do { _Pragma("unroll") for (int et = 0; et < 4; ++et) _Pragma("unroll") for (int dt = 0; dt < 2; ++dt) \
        S[et][dt] = __builtin_nontemporal_load((const f32x4*)((src) + (size_t)(32 * wid + 16 * dt + fr) * 512 + 16 * et + 4 * fq)); } while (0)
#define RET_WRITE_SLDS(S) do { _Pragma("unroll") for (int et = 0; et < 4; ++et) _Pragma("unroll") for (int dt = 0; dt < 2; ++dt) { \
        u32x2 w_; w_.x = cvt_pk_bf16(S[et][dt][0], S[et][dt][1]); w_.y = cvt_pk_bf16(S[et][dt][2], S[et][dt][3]); \
        *(LAS u32x2*)(lds + ((et & 1) ? asw1 : asw0) + 64 * (et >> 1) + dt * 3072) = w_; } } while (0)
#define RET_STORE_S(S, dst) do { _Pragma("unroll") for (int et = 0; et < 4; ++et) _Pragma("unroll") for (int dt = 0; dt < 2; ++dt) \
        __builtin_nontemporal_store(S[et][dt], (f32x4*)((dst) + (size_t)(32 * wid + 16 * dt + fr) * 512 + 16 * et + 4 * fq)); } while (0)
    auto load_chunk = [&](size_t rowb, int h, int es, u32x4 (&pq)[4], u32x4 (&pk)[4], u32x4& pv) __attribute__((always_inline)) {
        const size_t r = rowb + lrow;
#pragma unroll
        for (int it = 0; it < 4; ++it) { pq[it] = *(const u32x4*)(qb + r * 1024 + h * 256 + (piece + 8 * it) * 8); pk[it] = *(const u32x4*)(kb + r * 1024 + h * 256 + (piece + 8 * it) * 8); }
        pv = __builtin_nontemporal_load((const u32x4*)(vb + r * 2048 + h * 512 + es * 64 + piece * 8));
    };
    auto write_chunk = [&](const u32x4 (&pq)[4], const u32x4 (&pk)[4], const u32x4& pv) __attribute__((always_inline)) {
#pragma unroll
        for (int it = 0; it < 4; ++it) { *(LAS u32x4*)(lds + awq + it * 128) = pq[it]; *(LAS u32x4*)(lds + awq + 36864 + it * 128) = pk[it]; }
        *(LAS u32x4*)(lds + awv) = pv;
    };
    auto compute = [&](f32x4 (&S)[4][2], int h, int es, size_t rowb) __attribute__((always_inline)) {
        const float lg = lg2g(h), carry = exp2f(64.0f * lg);
        {   f32x4 sacc0 = {0.f, 0.f, 0.f, 0.f}, sacc1 = {0.f, 0.f, 0.f, 0.f};
#pragma unroll
            for (int kk = 0; kk < 8; ++kk) { const bf16x8 kf = RD128(ak1 + kk * 64); sacc0 = MFMA16(kf, RD128(aq0 + kk * 64), sacc0); sacc1 = MFMA16(kf, RD128(aq1 + kk * 64), sacc1); }
            const int j0 = 16 * hw + 4 * fq;
#pragma unroll
            for (int u = 0; u < 2; ++u) { const int i = rQ0 + 16 * u; const f32x4 sa = u ? sacc1 : sacc0; float v[4];
#pragma unroll
                for (int jj = 0; jj < 4; ++jj) { const int j = j0 + jj; const int ex = (j <= i) ? -64 : 2 * (j - i) - 64; v[jj] = sa[jj] * __builtin_amdgcn_exp2f(lg * (float)ex); }
                u32x2 w; w.x = cvt_pk_bf16(v[0], v[1]); w.y = cvt_pk_bf16(v[2], v[3]);
                *(LAS u32x2*)(lds + (u ? apw1 : apw0)) = w; }
        }
        LDS_BARRIER();
        {   f32x4 oacc0 = {0.f, 0.f, 0.f, 0.f}, oacc1 = {0.f, 0.f, 0.f, 0.f};
#pragma unroll
            for (int kk = 0; kk < 2; ++kk) { const bf16x8 vf = mk8(RDTR(av2 + kk * 6144), RDTR(av2 + kk * 6144 + 768)); oacc0 = MFMA16(vf, RD128(ap0 + kk * 64), oacc0); oacc1 = MFMA16(vf, RD128(ap1 + kk * 64), oacc1); }
#pragma unroll
            for (int kk = 0; kk < 8; ++kk) { const bf16x8 sf = mk8(RDTR(as20 + kk * 6144), RDTR(as21 + kk * 6144)); oacc0 = MFMA16(sf, RD128(aq0 + kk * 64), oacc0); oacc1 = MFMA16(sf, RD128(aq1 + kk * 64), oacc1); }
#pragma unroll
            for (int u = 0; u < 2; ++u) { const size_t r = rowb + rQ0 + 16 * u; const f32x4 o = u ? oacc1 : oacc0;
                float ss = (o[0] * o[0] + o[1] * o[1]) + (o[2] * o[2] + o[3] * o[3]);
                u32x2 w; w.x = cvt_pk_bf16(o[0], o[1]); w.y = cvt_pk_bf16(o[2], o[3]);
                *(u32x2*)(ob + r * 2048 + h * 512 + es * 64 + 16 * hw + 4 * fq) = w;
                ss += __shfl_xor(ss, 16); ss += __shfl_xor(ss, 32);
                if (fq == 0) ssq[r * 128 + h * 32 + es * 4 + hw] = ss; }
        }
#pragma unroll
        for (int et = 0; et < 4; ++et)
#pragma unroll
            for (int dt = 0; dt < 2; ++dt) S[et][dt] *= carry;
#pragma unroll
        for (int kk = 0; kk < 2; ++kk) {
            const bf16x8 kf0 = mk8(RDTR(ak30 + kk * 18432), RDTR(ak30 + kk * 18432 + 2304)), kf1 = mk8(RDTR(ak31 + kk * 18432), RDTR(ak31 + kk * 18432 + 2304));
#pragma unroll
            for (int et = 0; et < 4; ++et) { const int av = ((et & 1) ? av31 : av30) + 64 * (et >> 1) + kk * 6144; const bf16x8 vf = mk8(RDTR(av), RDTR(av + 768));
                S[et][0] = MFMA16(vf, kf0, S[et][0]); S[et][1] = MFMA16(vf, kf1, S[et][1]); }
        }
        LDS_BARRIER();
    };
    {   const RItem C = ret_prompt_item(p, bid);
        f32x4 Sc[4][2];
#pragma unroll
        for (int et = 0; et < 4; ++et)
#pragma unroll
            for (int dt = 0; dt < 2; ++dt) Sc[et][dt] = (f32x4){0.f, 0.f, 0.f, 0.f};
        u32x4 pqA[4], pkA[4], pvA, pqB[4], pkB[4], pvB;
        load_chunk(C.row0, C.h, C.es, pqA, pkA, pvA);
        load_chunk(C.row0 + 64, C.h, C.es, pqB, pkB, pvB);
        RET_WRITE_SLDS(Sc);
        for (int step = 0; step < 32; step += 2) {
            write_chunk(pqA, pkA, pvA); LDS_BARRIER();
            if (step + 2 < 32) load_chunk(C.row0 + (size_t)(step + 2) * 64, C.h, C.es, pqA, pkA, pvA);
            compute(Sc, C.h, C.es, C.row0 + (size_t)step * 64);
            RET_WRITE_SLDS(Sc);
            write_chunk(pqB, pkB, pvB); LDS_BARRIER();
            if (step + 3 < 32) load_chunk(C.row0 + (size_t)(step + 3) * 64, C.h, C.es, pqB, pkB, pvB);
            compute(Sc, C.h, C.es, C.row0 + (size_t)(step + 1) * 64);
            if (step + 2 < 32) RET_WRITE_SLDS(Sc);
        }
        RET_STORE_S(Sc, C.Sout);
    }
    {   RItem X = ret_sample_item(p, bid);
        f32x4 Sx[4][2], Sn[4][2]; u32x4 pq[4], pk[4], pv;
        RET_LOAD_S(Sx, X.S0); load_chunk(X.row0, X.h, X.es, pq, pk, pv);
        for (int k = 0; k < 4; ++k) {
            RET_WRITE_SLDS(Sx); write_chunk(pq, pk, pv); LDS_BARRIER();
            const RItem Y = ret_sample_item(p, bid + 256 * (k < 3 ? k + 1 : k));
            if (k < 3) { RET_LOAD_S(Sn, Y.S0); load_chunk(Y.row0, Y.h, Y.es, pq, pk, pv); }
            compute(Sx, X.h, X.es, X.row0);
            RET_STORE_S(Sx, X.Sout);
            if (k < 3) {
#pragma unroll
                for (int et = 0; et < 4; ++et)
#pragma unroll
                    for (int dt = 0; dt < 2; ++dt) Sx[et][dt] = Sn[et][dt];
                X = Y; }
        }
    }
#undef RD128
#undef RDTR
#undef RET_LOAD_S
#undef RET_WRITE_SLDS
#undef RET_STORE_S
}

__device__ __forceinline__ void phase_conv(const Params& p) {
    const size_t gtid = (size_t)blockIdx.x * 512 + threadIdx.x, gsz = (size_t)gridDim.x * 512;
    bf16_t* cbb = (bf16_t*)(p.ws + WS_Q); const bf16_t* ub = (const bf16_t*)(p.ws + WS_K);
    for (size_t idx = gtid; idx < (size_t)(NTOK / 4) * 128; idx += gsz) {
        const int r0 = (int)(idx >> 7) * 4, c = (int)(idx & 127) * 8;
        const bool smp = r0 >= NP; const int pos0 = smp ? ((r0 - NP) & 63) : (r0 & 2047);
        u32x4 uw[6], cw[4];
#pragma unroll
        for (int j = 0; j < 6; ++j) if (j >= 2 || pos0 >= 2) uw[j] = __builtin_nontemporal_load((const u32x4*)(ub + (size_t)(r0 - 2 + j) * 1024 + c));
#pragma unroll
        for (int j = 0; j < 4; ++j) cw[j] = __builtin_nontemporal_load((const u32x4*)(cbb + (size_t)(r0 + j) * 1024 + c));
        const f32x4 w0a = *(const f32x4*)(p.w_conv + c), w0b = *(const f32x4*)(p.w_conv + c + 4);
        const f32x4 w1a = *(const f32x4*)(p.w_conv + 1024 + c), w1b = *(const f32x4*)(p.w_conv + 1024 + c + 4);
        const f32x4 w2a = *(const f32x4*)(p.w_conv + 2048 + c), w2b = *(const f32x4*)(p.w_conv + 2048 + c + 4);
        f32x4 ua[6], uv[6];
#pragma unroll
        for (int j = 2; j < 6; ++j) unpack8(uw[j], ua[j], uv[j]);
        if (pos0 >= 2) { unpack8(uw[0], ua[0], uv[0]); unpack8(uw[1], ua[1], uv[1]); }
        else if (smp) { const float* cache = p.cache_conv + (size_t)((r0 - NP) >> 6) * 2048 + c;
            ua[0] = *(const f32x4*)cache; uv[0] = *(const f32x4*)(cache + 4); ua[1] = *(const f32x4*)(cache + 1024); uv[1] = *(const f32x4*)(cache + 1024 + 4); }
        else { ua[0] = (f32x4){0.f, 0.f, 0.f, 0.f}; uv[0] = ua[0]; ua[1] = ua[0]; uv[1] = ua[0]; }
#pragma unroll
        for (int j = 0; j < 4; ++j) {
            f32x4 ca, cbv; unpack8(cw[j], ca, cbv);
            const f32x4 ra = ca * (w0a * ua[j] + w1a * ua[j + 1] + w2a * ua[j + 2]), rb = cbv * (w0b * uv[j] + w1b * uv[j + 1] + w2b * uv[j + 2]);
            *(u32x4*)(cbb + (size_t)(r0 + j) * 1024 + c) = pack8(ra, rb);
        }
    }
}

__device__ __forceinline__ void phase_ln(float* x, const float* g, const float* bta, bf16_t* xb, float* stats = nullptr) {
    const int lane = threadIdx.x & 63, wv = (blockIdx.x * 512 + threadIdx.x) >> 6, nwv = gridDim.x * 8;
    f32x4 gg[4], bb[4];
#pragma unroll
    for (int i = 0; i < 4; ++i) { gg[i] = *(const f32x4*)(g + i * 256 + lane * 4); bb[i] = *(const f32x4*)(bta + i * 256 + lane * 4); }
    for (int r0 = wv; r0 < NTOK; r0 += 3 * nwv) {
        f32x4 v[3][4];
#pragma unroll
        for (int j = 0; j < 3; ++j) { const int r = r0 + j * nwv; if (r < NTOK) {
#pragma unroll
            for (int i = 0; i < 4; ++i) v[j][i] = __builtin_nontemporal_load((const f32x4*)(x + (size_t)r * 1024 + lane * 4 + i * 256)); } }
#pragma unroll
        for (int j = 0; j < 3; ++j) { const int r = r0 + j * nwv; if (r < NTOK) {
            float* rp = x + (size_t)r * 1024 + lane * 4; float s = 0.f;
#pragma unroll
            for (int i = 0; i < 4; ++i) s += (v[j][i][0] + v[j][i][1]) + (v[j][i][2] + v[j][i][3]);
#pragma unroll
            for (int o = 32; o >= 1; o >>= 1) s += __shfl_xor(s, o);
            const float mu = s * (1.0f / 1024.0f); float q = 0.f;
#pragma unroll
            for (int i = 0; i < 4; ++i) { v[j][i] -= mu; q += (v[j][i][0] * v[j][i][0] + v[j][i][1] * v[j][i][1]) + (v[j][i][2] * v[j][i][2] + v[j][i][3] * v[j][i][3]); }
#pragma unroll
            for (int o = 32; o >= 1; o >>= 1) q += __shfl_xor(q, o);
            const float rstd = rsqrtf(q * (1.0f / 1024.0f) + 1e-5f);
            if (stats && lane == 0) { stats[2 * r] = mu; stats[2 * r + 1] = rstd; }
#pragma unroll
            for (int i = 0; i < 4; ++i) { const f32x4 y = v[j][i] * rstd * gg[i] + bb[i]; if (!stats) __builtin_nontemporal_store(y, (f32x4*)(rp + i * 256));
                if (xb) { u32x2 w; w.x = cvt_pk_bf16(y[0], y[1]); w.y = cvt_pk_bf16(y[2], y[3]); *(u32x2*)(xb + (size_t)r * 1024 + i * 256 + lane * 4) = w; } }
        } }
    }
}

template <class Epi> __device__ __forceinline__ void run_gemm(LAS unsigned char* lds, Gemm g, Epi E) {
    StaticOrder S; S.init(g.M, g.N, (int)gridDim.x, (int)blockIdx.x); gemm_phase<Epi, StaticOrder>(lds, g, S, E, nullptr);
}
template <class Epi> __device__ __forceinline__ void run_gemm_head(LAS unsigned char* lds, Gemm g, Epi E) {
    RangeOrder S; S.init(g.M, g.N, (int)gridDim.x, (int)blockIdx.x); S.imax = 1; gemm_phase<Epi, RangeOrder>(lds, g, S, E, nullptr);
}
__device__ __forceinline__ void tile_sync(unsigned* cnt, unsigned want) {
    asm volatile("s_waitcnt vmcnt(0)" ::: "memory");
    __syncthreads();
    if (threadIdx.x == 0) {
        __hip_atomic_fetch_add(cnt, 1u, __ATOMIC_RELAXED, __HIP_MEMORY_SCOPE_AGENT);
        while (__hip_atomic_load(cnt, __ATOMIC_RELAXED, __HIP_MEMORY_SCOPE_AGENT) < want) __builtin_amdgcn_s_sleep(1);
        __builtin_amdgcn_fence(__ATOMIC_ACQUIRE, "agent");
        asm volatile("s_waitcnt vmcnt(0)" ::: "memory");
    }
    asm volatile("" ::: "memory");
    __syncthreads();
    asm volatile("" ::: "memory");
}
template <int NSL> __device__ __forceinline__ void slab_sum(const float* tile_slabs, int s, f32x4 (&out)[2][2][2]) {
    const unsigned long long* sp = (const unsigned long long*)tile_slabs + threadIdx.x;
#pragma unroll
    for (int c = 0; c < 2; ++c)
#pragma unroll
        for (int bj = 0; bj < 2; ++bj)
#pragma unroll
            for (int n = 0; n < 2; ++n) { const int idx = (((2 * s + c) * 2 + bj) * 2 + n) * 2;
                f32x4 v = {0.f, 0.f, 0.f, 0.f};
#pragma unroll
                for (int sl = 0; sl < NSL; ++sl) {
                    const unsigned long long lo = __hip_atomic_load(sp + (size_t)sl * 32768 + (size_t)idx * 512, __ATOMIC_RELAXED, __HIP_MEMORY_SCOPE_AGENT);
                    const unsigned long long hi = __hip_atomic_load(sp + (size_t)sl * 32768 + (size_t)(idx + 1) * 512, __ATOMIC_RELAXED, __HIP_MEMORY_SCOPE_AGENT);
                    v[0] += __uint_as_float((unsigned)lo); v[1] += __uint_as_float((unsigned)(lo >> 32)); v[2] += __uint_as_float((unsigned)hi); v[3] += __uint_as_float((unsigned)(hi >> 32)); }
                out[c][bj][n] = v; }
}
__device__ __forceinline__ void merge_tails(LAS unsigned char* lds, Gemm gr, Gemm gc, bf16_t* mb, const bf16_t* sgr, const bf16_t* sgc, float* rslabs, float* cslabs, unsigned* rcnt, unsigned* ccnt) {
    const int b = (int)blockIdx.x; if (b >= 192) return;
    const bool isr = b < 128; const int tile = isr ? (b >> 2) : ((b - 128) >> 1), s = isr ? (b & 3) : (b & 1);
    StaticOrder T; T.init(gr.M, gr.N, (int)gridDim.x, 0); T.c = (int)gridDim.x + tile; OneUnit S; T.next(0, S.u0);
    Gemm gs = isr ? gr : gc; gs.ld = gs.K; gs.A += s * 512; gs.Bt += s * 512; gs.K = 512;
    EpiSlab<true> ES{isr ? rslabs + (size_t)(tile * 4 + s) * 65536 : cslabs + (size_t)(tile * 2 + s) * 65536};
    gemm_phase<EpiSlab<true>, OneUnit>(lds, gs, S, ES, nullptr);
    asm volatile("s_waitcnt vmcnt(0)" ::: "memory");
    __syncthreads();
    if (threadIdx.x == 0) {
        __hip_atomic_fetch_add((isr ? rcnt : ccnt) + tile * 16, 1u, __ATOMIC_RELAXED, __HIP_MEMORY_SCOPE_AGENT);
        if (isr) {
            while (__hip_atomic_load(rcnt + tile * 16, __ATOMIC_RELAXED, __HIP_MEMORY_SCOPE_AGENT) < 4u) __builtin_amdgcn_s_sleep(1);
            while (__hip_atomic_load(ccnt + tile * 16, __ATOMIC_RELAXED, __HIP_MEMORY_SCOPE_AGENT) < 2u) __builtin_amdgcn_s_sleep(1);
            __builtin_amdgcn_fence(__ATOMIC_ACQUIRE, "agent");
            asm volatile("s_waitcnt vmcnt(0)" ::: "memory");
        }
    }
    asm volatile("" ::: "memory");
    __syncthreads();
    asm volatile("" ::: "memory");
    if (!isr) return;
    f32x4 ar[2][2][2], ac[2][2][2];
    slab_sum<4>(rslabs + (size_t)(tile * 4) * 65536, s, ar);
    slab_sum<2>(cslabs + (size_t)(tile * 2) * 65536, s, ac);
    const int tid = threadIdx.x, wid = tid >> 6, lane = tid & 63, wr = wid >> 2, wc = wid & 3, fr = lane & 15, fq = lane >> 4;
    const int row0 = S.u0.pm * BM + wr * 64 + fr, col = S.u0.pn * BM + wc * 32 + 8 * fq;
#pragma unroll
    for (int c = 0; c < 2; ++c) {
        const int cmb = 2 * s + c, ai = cmb >> 2, m = cmb & 3;
        const size_t off = (size_t)(row0 + ai * HALF + m * 16) * 1024 + col;
#pragma unroll
        for (int bj = 0; bj < 2; ++bj) {
            f32x4 ga, gb, ha, hb; unpack8(*(const u32x4*)(sgr + off + bj * HALF), ga, gb); unpack8(*(const u32x4*)(sgc + off + bj * HALF), ha, hb);
            *(u32x4*)(mb + off + bj * HALF) = pack8(ar[c][bj][0] * ga + ac[c][bj][0] * ha, ar[c][bj][1] * gb + ac[c][bj][1] * hb);
        }
    }
}
template <class Epi> __device__ __forceinline__ void run_gemm_tail(LAS unsigned char* lds, Gemm g, Epi E, int k0, int klen, float* slabs, unsigned* cnt) {
    const int b = (int)blockIdx.x; if (b >= 128) return;
    const int tile = b >> 2, s = b & 3;
    StaticOrder T; T.init(g.M, g.N, (int)gridDim.x, 0); T.c = (int)gridDim.x + tile; OneUnit S; T.next(0, S.u0);
    Gemm gs = g; gs.ld = g.ld ? g.ld : g.K; gs.A = g.A + k0; gs.Bt = g.Bt + k0; gs.K = klen;
    EpiSlab<Epi::PERM> ES{slabs + (size_t)(tile * 4 + s) * 65536};
    gemm_phase<EpiSlab<Epi::PERM>, OneUnit>(lds, gs, S, ES, nullptr);
    tile_sync(cnt + tile * 16, 4u);
    f32x4 acc[2][2][4][2];
    const unsigned long long* sp = (const unsigned long long*)(slabs + (size_t)(tile * 4) * 65536) + threadIdx.x;
#pragma unroll
    for (int ai = 0; ai < 2; ++ai)
#pragma unroll
        for (int m = 0; m < 4; ++m) {
            if (((ai * 4 + m) >> 1) != s) continue;
#pragma unroll
            for (int bj = 0; bj < 2; ++bj)
#pragma unroll
                for (int n = 0; n < 2; ++n) { const int idx = (((ai * 4 + m) * 2 + bj) * 2 + n) * 2;
                    unsigned long long lo[4], hi[4];
#pragma unroll
                    for (int sl = 0; sl < 4; ++sl) { lo[sl] = __hip_atomic_load(sp + (size_t)sl * 32768 + (size_t)idx * 512, __ATOMIC_RELAXED, __HIP_MEMORY_SCOPE_AGENT);
                                                     hi[sl] = __hip_atomic_load(sp + (size_t)sl * 32768 + (size_t)(idx + 1) * 512, __ATOMIC_RELAXED, __HIP_MEMORY_SCOPE_AGENT); }
                    f32x4 v;
                    v[0] = (__uint_as_float((unsigned)lo[0]) + __uint_as_float((unsigned)lo[1])) + (__uint_as_float((unsigned)lo[2]) + __uint_as_float((unsigned)lo[3]));
                    v[1] = (__uint_as_float((unsigned)(lo[0] >> 32)) + __uint_as_float((unsigned)(lo[1] >> 32))) + (__uint_as_float((unsigned)(lo[2] >> 32)) + __uint_as_float((unsigned)(lo[3] >> 32)));
                    v[2] = (__uint_as_float((unsigned)hi[0]) + __uint_as_float((unsigned)hi[1])) + (__uint_as_float((unsigned)hi[2]) + __uint_as_float((unsigned)hi[3]));
                    v[3] = (__uint_as_float((unsigned)(hi[0] >> 32)) + __uint_as_float((unsigned)(hi[1] >> 32))) + (__uint_as_float((unsigned)(hi[2] >> 32)) + __uint_as_float((unsigned)(hi[3] >> 32)));
                    acc[ai][bj][m][n] = v; }
        }
    E.selmask = 3u << (2 * s);
    const int tid = threadIdx.x, wid = tid >> 6, lane = tid & 63;
    E(acc, S.u0, wid >> 2, wid & 3, lane & 15, lane >> 4);
}
constexpr int NPHASE = 11;
__global__ void __launch_bounds__(512, 2) mega(Params p) {
    extern __shared__ __attribute__((aligned(16))) unsigned char lds_raw[];
    LAS unsigned char* lds = (LAS unsigned char*)lds_raw;
    cg::grid_group grid = cg::this_grid();
    unsigned char* ws = p.ws;
    volatile LAS unsigned* xst = (volatile LAS unsigned*)(lds + 147456);
    if (threadIdx.x == 0) { xst[0] = 0u; xst[1] = 0u; }
    __syncthreads();
    const XcdBarrier xb = xcd_barrier_post((unsigned*)(ws + WS_BAR), xst);
#if MK_LAUNCHES == 1
#define RUN(k) true
#define SYNC() xcd_barrier(xb)
#define SYNC0() do { if (p.ph_lo > 1000) grid.sync(); xcd_barrier(xb); } while (0)
#else
#define RUN(k) (p.ph_lo == (k))
#define SYNC() do {} while (0)
#define SYNC0() do {} while (0)
#endif
    if (RUN(0)) phase_convert(p, lds, 0);
    SYNC0();
    if (RUN(1)) { Gemm g{(const bf16_t*)(ws + WS_XB), (const bf16_t*)(ws + WS_WIN), NTOK, 4096, 1024}; Epi1a E{(bf16_t*)(ws + WS_Q), (bf16_t*)(ws + WS_K), (bf16_t*)(ws + WS_V), (const float*)(ws + WS_ROPE)}; run_gemm<Epi1a>(lds, g, E);  if (blockIdx.x >= 128) phase_convert(p, lds, 1); }
    SYNC();
    if (RUN(2)) phase_retention(p, lds);
    SYNC();
    if (RUN(3)) { Gemm g{(const bf16_t*)(ws + WS_XB), (const bf16_t*)(ws + WS_WIN) + (size_t)4096 * 1024, NTOK, 7168, 1024}; Epi1b E{(bf16_t*)p.out, (bf16_t*)(ws + WS_Q), (bf16_t*)(ws + WS_K), (bf16_t*)(ws + WS_V), (bf16_t*)(ws + WS_V) + (size_t)NTOK * 1024, (const float*)(ws + WS_SSQ), p.out}; run_gemm<Epi1b>(lds, g, E); }
    SYNC();
    if (RUN(4)) phase_conv(p);
    SYNC();
    if (RUN(5)) {
        unsigned* tc = (unsigned*)(ws + WS_BAR) + XCD_BAR_WORDS;
        Gemm gr{(const bf16_t*)p.out, (const bf16_t*)(ws + WS_WR), NTOK, 1024, 2048, 2048}; EpiMerge<0> Er{(bf16_t*)(ws + WS_XB), (const bf16_t*)(ws + WS_V), 0xffu};
        Gemm gc{(const bf16_t*)(ws + WS_Q), (const bf16_t*)(ws + WS_WC), NTOK, 1024, 1024, 1024}; EpiMerge<1> Ec{(bf16_t*)(ws + WS_XB), (const bf16_t*)(ws + WS_V) + (size_t)NTOK * 1024, 0xffu};
        run_gemm_head<EpiMerge<0>>(lds, gr, Er);
        run_gemm_head<EpiMerge<1>>(lds, gc, Ec);
        merge_tails(lds, gr, gc, (bf16_t*)(ws + WS_XB), (const bf16_t*)(ws + WS_V), (const bf16_t*)(ws + WS_V) + (size_t)NTOK * 1024, (float*)(ws + WS_K), (float*)(ws + WS_CSLAB), tc, tc + 1024);
        if (blockIdx.x >= 192) phase_convert(p, lds, 2);
    }
    SYNC();
    if (RUN(6)) { Gemm g{(const bf16_t*)(ws + WS_XB), (const bf16_t*)(ws + WS_WO), NTOK, 1024, 1024, 1024}; EpiRes E{p.x_prompt, p.x_sample, p.out, 0xffu};
        run_gemm_head<EpiRes>(lds, g, E);
        run_gemm_tail<EpiRes>(lds, g, E, ((int)blockIdx.x & 3) * 256, 256, (float*)(ws + WS_K), (unsigned*)(ws + WS_BAR) + XCD_BAR_WORDS + 1536);
        if (blockIdx.x >= 128) phase_convert(p, lds, 3); }
    SYNC();
    if (RUN(7)) phase_ln(p.out, p.ln1_g, p.ln1_b, (bf16_t*)(ws + WS_XB), (float*)(ws + WS_ROPE));
    SYNC();
    if (RUN(8)) { Gemm g{(const bf16_t*)(ws + WS_XB), (const bf16_t*)(ws + WS_WUP), NTOK, 5632, 1024}; EpiUp E{(bf16_t*)(ws + WS_Q)}; run_gemm<EpiUp>(lds, g, E); }
    SYNC();
    if (RUN(9)) { Gemm g{(const bf16_t*)(ws + WS_Q), (const bf16_t*)(ws + WS_WD), NTOK, 1024, 2816, 2816}; EpiResLn E{p.out, p.ln1_g, p.ln1_b, (const float*)(ws + WS_ROPE), 0xffu};
        const int s4 = (int)blockIdx.x & 3;
        run_gemm_head<EpiResLn>(lds, g, E);
        run_gemm_tail<EpiResLn>(lds, g, E, s4 < 2 ? s4 * 768 : 1536 + (s4 - 2) * 640, s4 < 2 ? 768 : 640, (float*)(ws + WS_V + ((size_t)32 << 20)), (unsigned*)(ws + WS_BAR) + XCD_BAR_WORDS + 2048); }
    SYNC();
    if (RUN(10)) phase_ln(p.out, p.ln2_g, p.ln2_b, nullptr);
}

constexpr int LDS_BYTES = 147456 + 16;
extern "C" void kernel_launch(void* const* d_in, const int* in_sizes, int n_in, void* d_out, int out_size, void* d_ws, size_t ws_size, hipStream_t stream) {
    static int grid = 0;
    if (grid == 0) {
        if (n_in != 15 || ws_size < WS_END) { fprintf(stderr, "kernel_launch: need 15 inputs and %zu bytes of workspace; got %d, %zu\n", (size_t)WS_END, n_in, ws_size); grid = -1; return; }
        int dev = 0, cus = 0, per_cu = 0;
        hipGetDevice(&dev); hipDeviceGetAttribute(&cus, hipDeviceAttributeMultiprocessorCount, dev);
        if (hipFuncSetAttribute((const void*)mega, hipFuncAttributeMaxDynamicSharedMemorySize, LDS_BYTES) != hipSuccess) { fprintf(stderr, "kernel_launch: hipFuncSetAttribute failed\n"); grid = -1; return; }
        if (hipOccupancyMaxActiveBlocksPerMultiprocessor(&per_cu, (const void*)mega, 512, LDS_BYTES) != hipSuccess || per_cu < 1) { fprintf(stderr, "kernel_launch: occupancy query says %d\n", per_cu); per_cu = 1; }
        (void)hipGetLastError();
        grid = cus;
        if (grid != 256) { fprintf(stderr, "kernel_launch: built for a 256-CU device, found %d CUs\n", cus); grid = -1; return; }
        fprintf(stderr, "kernel_launch: grid %d (per_cu %d)\n", grid, per_cu);
    }
    if (grid < 0) return;
    if (hipMemsetAsync((char*)d_ws + WS_BAR, 0, (XCD_BAR_WORDS + TAIL_CNT_WORDS) * 4, stream) != hipSuccess) { fprintf(stderr, "kernel_launch: memset of barrier words failed\n"); return; }
    Params p{};
    p.x_prompt = (const float*)d_in[0]; p.x_sample = (const float*)d_in[1]; p.state_ret = (const float*)d_in[2]; p.cache_conv = (const float*)d_in[3];
    p.w_in = (const float*)d_in[4]; p.w_conv = (const float*)d_in[5]; p.w_ret_out = (const float*)d_in[6]; p.w_conv_out = (const float*)d_in[7]; p.w_o = (const float*)d_in[8];
    p.ln1_g = (const float*)d_in[9]; p.ln1_b = (const float*)d_in[10]; p.w_up = (const float*)d_in[11]; p.w_down = (const float*)d_in[12]; p.ln2_g = (const float*)d_in[13]; p.ln2_b = (const float*)d_in[14];
    p.out = (float*)d_out; p.ws = (unsigned char*)d_ws;
#if MK_LAUNCHES == 1
    p.ph_lo = 0; p.ph_hi = NPHASE;
    void* args[] = {&p};
    hipError_t e = hipLaunchCooperativeKernel((const void*)mega, dim3(grid), dim3(512), args, LDS_BYTES, stream);
    if (e != hipSuccess) fprintf(stderr, "cooperative launch failed: %s (grid %d)\n", hipGetErrorString(e), grid);
#else
    for (int ph = 0; ph < NPHASE; ++ph) { p.ph_lo = ph; p.ph_hi = ph + 1; hipLaunchKernelGGL(mega, dim3(grid), dim3(512), LDS_BYTES, stream, p); }
#endif
}
```

```cpp
#include <hip/hip_runtime.h>
#include <hip/hip_cooperative_groups.h>
#include <cstdio>
namespace cg = cooperative_groups;
#ifndef MK_LAUNCHES
#define MK_LAUNCHES 1
#endif
namespace pg8 {
#define PG8_LAS __attribute__((address_space(3)))
typedef unsigned short bf16_t;
typedef short bf16x8 __attribute__((ext_vector_type(8)));
typedef float f32x4 __attribute__((ext_vector_type(4)));
typedef unsigned u32x4 __attribute__((ext_vector_type(4)));
constexpr int BM = 256, BK = 64, HALF = 128, HTB = HALF * BK * 2  , STAGE_BYTES = 8 * HTB, NXCD = 8, WGM = 8;

__host__ __device__ __forceinline__ int lds_byte(int r, int c) { const int st = (r >> 4) * 2 + (c >> 5), rr = r & 15, cc = c & 31, ob = rr * 64 + cc * 2; return st * 1024 + (ob ^ (((ob >> 9) & 1) << 5)); }
__host__ __device__ __forceinline__ void stage_rc(int b, int& R, int& C) { const int st = b / 1024, sb = b % 1024, swz = sb ^ (((sb >> 9) & 1) << 5); R = (st >> 1) * 16 + swz / 64; C = (st & 1) * 32 + (swz % 64) / 2; }
__host__ __device__ __forceinline__ int perm32(int rho) { const int n = rho >> 4, i = rho & 15; return 8 * (i >> 2) + 4 * n + (i & 3); }

struct Unit { int pm, pn; };
struct Gemm { const bf16_t* A; const bf16_t* Bt; int M, N, K; int ld; };

struct StaticOrder {
    int nM, nN, nwg, G, c;
    __host__ __device__ void init(int M, int N, int G_, int c_) { nM = M / BM; nN = N / BM; nwg = nM * nN; G = G_; c = c_; }
    __host__ __device__ bool next(int i, Unit& u) const {
        const long L = (long)i * G + c; if (L >= nwg) return false;
        int wgid = (int)L; { const int q = nwg / NXCD, r = nwg % NXCD, xcd = wgid % NXCD, off = wgid / NXCD; wgid = (xcd < r ? xcd * (q + 1) : r * (q + 1) + (xcd - r) * q) + off; }
        const int nig = WGM * nN, gid = wgid / nig, fm = gid * WGM, gsz = (nM - fm) < WGM ? (nM - fm) : WGM;
        u.pm = fm + ((wgid % nig) % gsz); u.pn = (wgid % nig) / gsz; return true;
    }
    __device__ __forceinline__ void a_ready(const Unit&) const {}
    __device__ __forceinline__ void done(const Unit&) const {}
};
typedef __bf16 bf16x2_t __attribute__((ext_vector_type(2)));
typedef float f32x2_t __attribute__((ext_vector_type(2)));
__device__ __forceinline__ unsigned cvt_pk_bf16(float lo, float hi) { const f32x2_t v = {lo, hi}; return __builtin_bit_cast(unsigned, __builtin_convertvector(v, bf16x2_t)); }
template <class Epi, class Sched, bool STAMP = false>
__device__ __forceinline__ void gemm_phase(PG8_LAS unsigned char* lds, const Gemm g, const Sched& S, const Epi& E, unsigned long long* stamps) {
    int tid_ = threadIdx.x; asm volatile("" : "+v"(tid_));
    const int tid = tid_, wid = __builtin_amdgcn_readfirstlane(tid >> 6), lane = tid & 63, wr = wid >> 2, wc = wid & 3, fr = lane & 15, fq = lane >> 4;
    const int K = g.K, nt = K / BK, LD = g.ld ? g.ld : g.K;
    int ts_lo = 0, ts_hi = 0, nts = 0; const unsigned long long rt_entry = STAMP ? (unsigned long long)wall_clock64() : 0ull;
#define PG8_STAMP() do { if (STAMP && wid == 0 && nts < 64) { const unsigned long long _c = (unsigned long long)clock64(); \
        ts_lo = (lane == nts) ? (int)(unsigned)_c : ts_lo; ts_hi = (lane == nts) ? (int)(unsigned)(_c >> 32) : ts_hi; ++nts; } } while (0)
    PG8_STAMP();
    unsigned voffA[2], voffB[2];
#pragma unroll
    for (int i = 0; i < 2; ++i) { int R, C; stage_rc(tid * 16 + i * 8192, R, C); const int Rb = Epi::PERM ? ((R & ~31) + perm32(R & 31)) : R;
        voffA[i] = (unsigned)(R * LD + C) * 2u; voffB[i] = (unsigned)(Rb * LD + C) * 2u; }
    const size_t kstep = (size_t)(BK * 2);
    const size_t hstep = (size_t)HALF * LD * 2;
    const size_t tstep = 2 * hstep;
    const unsigned ldsw = (unsigned)wid * 1024u;
    const int aoff = lds_byte(wr * 64 + fr, fq * 8), boff = lds_byte(wc * 32 + fr, fq * 8);
#define PG8_SA(b, h) (((b) * 2 + (h)) * HTB)
#define PG8_SB(b, h) ((4 + (b) * 2 + (h)) * HTB)
#define PG8_STAGE(bufoff, gbase, voff) do { _Pragma("unroll") for (int _i = 0; _i < 2; ++_i) \
        __builtin_amdgcn_global_load_lds((const unsigned*)((const char*)(gbase) + (voff)[_i]), (PG8_LAS unsigned*)(lds + (bufoff) + ldsw + _i * 8192), 16, 0, 0); } while (0)
#define PG8_LDA(dst, b, h) do { _Pragma("unroll") for (int m = 0; m < 4; ++m) _Pragma("unroll") for (int k = 0; k < 2; ++k) dst[m][k] = *(const PG8_LAS bf16x8*)(lds + PG8_SA(b, h) + aoff + m * 2048 + k * 1024); } while (0)
#define PG8_LDB(dst, b, h) do { _Pragma("unroll") for (int n = 0; n < 2; ++n) _Pragma("unroll") for (int k = 0; k < 2; ++k) dst[n][k] = *(const PG8_LAS bf16x8*)(lds + PG8_SB(b, h) + boff + n * 2048 + k * 1024); } while (0)
#define PG8_MMA(ai, bj, At, Bt) do { __builtin_amdgcn_s_setprio(1); _Pragma("unroll") for (int m = 0; m < 4; ++m) _Pragma("unroll") for (int n = 0; n < 2; ++n) _Pragma("unroll") for (int k = 0; k < 2; ++k) \
        acc[ai][bj][m][n] = __builtin_amdgcn_mfma_f32_16x16x32_bf16(Bt[n][k], At[m][k], acc[ai][bj][m][n], 0, 0, 0); __builtin_amdgcn_s_setprio(0); } while (0)
#define PG8_WAIT_V(n) asm volatile("s_waitcnt vmcnt(" #n ")" ::: "memory")
#define PG8_WAIT_L(n) asm volatile("s_waitcnt lgkmcnt(" #n ")" ::: "memory")
#define PG8_BAR __builtin_amdgcn_s_barrier()
#define PG8_SCHED __builtin_amdgcn_sched_barrier(0)
    Unit cur, nxt; int ui = 0;
    if (!S.next(0, cur)) return;
    f32x4 acc[2][2][4][2];
#pragma unroll
    for (int a = 0; a < 2; ++a)
#pragma unroll
        for (int b = 0; b < 2; ++b)
#pragma unroll
            for (int m = 0; m < 4; ++m)
#pragma unroll
                for (int n = 0; n < 2; ++n) acc[a][b][m][n] = (f32x4){0.f, 0.f, 0.f, 0.f};
    bf16x8 At[4][2], B0[2][2], B1[2][2];
    const char* cA = (const char*)g.A + (size_t)cur.pm * tstep; const char* cB = (const char*)g.Bt + (size_t)cur.pn * tstep;
    S.a_ready(cur);
    PG8_STAGE(PG8_SB(0, 0), cB, voffB); PG8_STAGE(PG8_SA(0, 0), cA, voffA); PG8_STAGE(PG8_SB(0, 1), cB + hstep, voffB); PG8_STAGE(PG8_SA(0, 1), cA + hstep, voffA);
    if (wr == 1) PG8_BAR;
    PG8_WAIT_V(4); PG8_BAR;
    PG8_STAGE(PG8_SB(1, 0), cB + kstep, voffB); PG8_STAGE(PG8_SA(1, 0), cA + kstep, voffA); PG8_STAGE(PG8_SB(1, 1), cB + hstep + kstep, voffB);
    PG8_WAIT_V(6); PG8_BAR;
    PG8_STAMP();
    for (;;) {
        const bool has_next = S.next(ui + 1, nxt);
        const char* nA = has_next ? (const char*)g.A + (size_t)nxt.pm * tstep : cA; const char* nB = has_next ? (const char*)g.Bt + (size_t)nxt.pn * tstep : cB;
        for (int t = 0; t < nt; t += 2) {
            const bool last = (t == nt - 2);
            const char* a1 = cA + (size_t)(t + 1) * kstep;
            const char* a2 = last ? nA : cA + (size_t)(t + 2) * kstep; const char* b2 = last ? nB : cB + (size_t)(t + 2) * kstep;
            const char* a3 = a2 + kstep; const char* b3 = b2 + kstep;
            if (last && has_next) S.a_ready(nxt);
            PG8_LDB(B0, 0, 0); PG8_SCHED; PG8_LDA(At, 0, 0); PG8_STAGE(PG8_SA(1, 1), a1 + hstep, voffA);
            PG8_WAIT_L(8); PG8_BAR; PG8_WAIT_L(0); PG8_MMA(0, 0, At, B0); PG8_BAR; PG8_SCHED;
            PG8_LDB(B1, 0, 1); PG8_STAGE(PG8_SB(0, 0), b2, voffB);
            PG8_BAR; PG8_WAIT_L(0); PG8_MMA(0, 1, At, B1); PG8_BAR;
            PG8_LDA(At, 0, 1); PG8_STAGE(PG8_SA(0, 0), a2, voffA);
            PG8_BAR; PG8_WAIT_L(0); PG8_MMA(1, 0, At, B0); PG8_BAR; PG8_SCHED;
            PG8_STAGE(PG8_SB(0, 1), b2 + hstep, voffB);
            PG8_WAIT_V(6); PG8_BAR; PG8_MMA(1, 1, At, B1); PG8_BAR;
            PG8_LDB(B0, 1, 0); PG8_SCHED; PG8_LDA(At, 1, 0); PG8_STAGE(PG8_SA(0, 1), a2 + hstep, voffA);
            PG8_WAIT_L(8); PG8_BAR; PG8_WAIT_L(0); PG8_MMA(0, 0, At, B0); PG8_BAR; PG8_SCHED;
            PG8_LDB(B1, 1, 1); PG8_STAGE(PG8_SB(1, 0), b3, voffB);
            PG8_BAR; PG8_WAIT_L(0); PG8_MMA(0, 1, At, B1); PG8_BAR;
            PG8_LDA(At, 1, 1); PG8_STAGE(PG8_SA(1, 0), a3, voffA);
            PG8_BAR; PG8_WAIT_L(0); PG8_MMA(1, 0, At, B0); PG8_BAR; PG8_SCHED;
            PG8_STAGE(PG8_SB(1, 1), b3 + hstep, voffB);
            PG8_WAIT_V(6); PG8_BAR; PG8_MMA(1, 1, At, B1); PG8_BAR;
        }
        PG8_STAMP();
        if constexpr (!Epi::AFTER_DRAIN) { E(acc, cur, wr, wc, fr, fq); S.done(cur); }
        PG8_STAMP();
        if (!has_next) break;
#pragma unroll
        for (int a = 0; a < 2; ++a)
#pragma unroll
            for (int b = 0; b < 2; ++b)
#pragma unroll
                for (int m = 0; m < 4; ++m)
#pragma unroll
                    for (int n = 0; n < 2; ++n) acc[a][b][m][n] = (f32x4){0.f, 0.f, 0.f, 0.f};
        cur = nxt; cA = nA; cB = nB; ++ui;
    }
    PG8_WAIT_V(0);
    if (wr == 0) PG8_BAR;
    PG8_BAR;
    if constexpr (Epi::AFTER_DRAIN) { E.fused(acc, cur, wr, wc, fr, fq, lds, wid, lane); S.done(cur); }
    PG8_STAMP();
    if (STAMP && wid == 0) { stamps[lane] = lane < nts ? (((unsigned long long)(unsigned)ts_hi << 32) | (unsigned)ts_lo) : 0ull;
        if (lane == 62) stamps[62] = rt_entry; if (lane == 63) stamps[63] = (unsigned long long)wall_clock64(); }
#undef PG8_STAMP
#undef PG8_SA
#undef PG8_SB
#undef PG8_STAGE
#undef PG8_LDA
#undef PG8_LDB
#undef PG8_MMA
#undef PG8_WAIT_V
#undef PG8_WAIT_L
#undef PG8_BAR
#undef PG8_SCHED
}
}
using namespace pg8;
typedef short s16x4 __attribute__((ext_vector_type(4)));
typedef unsigned u32x2 __attribute__((ext_vector_type(2)));
#define LAS PG8_LAS

struct RangeOrder : StaticOrder {
    int imax;
    __device__ __forceinline__ bool next(int i, Unit& u) const { if (i >= imax) return false; return StaticOrder::next(i, u); }
};
struct OneUnit {
    Unit u0;
    __device__ __forceinline__ bool next(int i, Unit& u) const { if (i) return false; u = u0; return true; }
    __device__ __forceinline__ void a_ready(const Unit&) const {}
    __device__ __forceinline__ void done(const Unit&) const {}
};
template <bool PERM_> struct EpiSlab {
    static constexpr bool PERM = PERM_, AFTER_DRAIN = false;
    float* slab;
    __device__ __forceinline__ void operator()(const f32x4 (&acc)[2][2][4][2], const Unit&, int, int, int, int) const {
        unsigned long long* sp = (unsigned long long*)slab + threadIdx.x;
#pragma unroll
        for (int ai = 0; ai < 2; ++ai)
#pragma unroll
            for (int m = 0; m < 4; ++m)
#pragma unroll
                for (int bj = 0; bj < 2; ++bj)
#pragma unroll
                    for (int n = 0; n < 2; ++n) { const f32x4 v = acc[ai][bj][m][n]; const int idx = (((ai * 4 + m) * 2 + bj) * 2 + n) * 2;
                        __hip_atomic_store(sp + (size_t)idx * 512, ((unsigned long long)__float_as_uint(v[1]) << 32) | __float_as_uint(v[0]), __ATOMIC_RELAXED, __HIP_MEMORY_SCOPE_AGENT);
                        __hip_atomic_store(sp + (size_t)(idx + 1) * 512, ((unsigned long long)__float_as_uint(v[3]) << 32) | __float_as_uint(v[2]), __ATOMIC_RELAXED, __HIP_MEMORY_SCOPE_AGENT); }
    }
};
#define XB_TMO      128
#define XB_XCNT(j)  (256  + 64 * (j))
#define XB_XSUB(j)  (1280 + 64 * (j))
#define XB_XGEN(j)  (2304 + 64 * (j))
#define XB_TOP      3328
#define XB_TOPGEN   3392
#define XCD_BAR_WORDS 3456
#define XB_SPIN_CAP (1u << 18)

__device__ __forceinline__ unsigned xb_ld(unsigned* p)              { return __hip_atomic_load(p, __ATOMIC_RELAXED, __HIP_MEMORY_SCOPE_AGENT); }
__device__ __forceinline__ unsigned xb_add(unsigned* p, unsigned v) { return __hip_atomic_fetch_add(p, v, __ATOMIC_RELAXED, __HIP_MEMORY_SCOPE_AGENT); }
__device__ __forceinline__ unsigned xb_xcc_id() { return (unsigned)__builtin_amdgcn_s_getreg((3 << 11) | 20) & 0xFu; }
#define XB_SPIN(cond, bar) do { unsigned _sp = 0; while (cond) { __builtin_amdgcn_s_sleep(1); \
    if ((++_sp & 255u) == 0u) { if (xb_ld(&(bar)[XB_TMO])) break; if (_sp > XB_SPIN_CAP) { atomicAdd(&(bar)[XB_TMO], 1u); break; } } } } while (0)

struct XcdBarrier {
    unsigned* bar; unsigned x;
    volatile LAS unsigned* st;
};

__device__ __forceinline__ XcdBarrier xcd_barrier_post(unsigned* bar, volatile LAS unsigned* st) {
    XcdBarrier b; b.bar = bar; b.x = xb_xcc_id(); b.st = st;
    if (threadIdx.x == 0) (void)xb_add(&bar[XB_XCNT(b.x)], 1u);
    return b;
}
__device__ __forceinline__ void xcd_barrier_complete(unsigned* bar, unsigned x, unsigned& nloc, unsigned& nx) {
    const unsigned G = gridDim.x * gridDim.y * gridDim.z;
    unsigned sum, cnt, mine, sp = 0u;
    for (;;) {
        sum = 0u; cnt = 0u; mine = 0u;
#pragma unroll
        for (unsigned j = 0; j < 16; ++j) { const unsigned c = xb_ld(&bar[XB_XCNT(j)]); sum += c; cnt += (c > 0u) ? 1u : 0u; mine = (j == x) ? c : mine; }
        if (sum == G) break;
        __builtin_amdgcn_s_sleep(1);
        if ((++sp & 255u) == 0u) { if (xb_ld(&bar[XB_TMO])) break; if (sp > XB_SPIN_CAP) { atomicAdd(&bar[XB_TMO], 1u); break; } }
    }
    nloc = mine > 0u ? mine : 1u; nx = cnt > 0u ? cnt : 1u;
}

__device__ __forceinline__ void xcd_barrier(const XcdBarrier& b) {
    asm volatile("s_waitcnt vmcnt(0)" ::: "memory");
    __syncthreads();
    if (threadIdx.x == 0) {
        unsigned* bar = b.bar;
        __builtin_amdgcn_s_waitcnt(0);
        unsigned nloc = b.st[0], nx = b.st[1];
        if (nloc == 0u) { xcd_barrier_complete(bar, b.x, nloc, nx); b.st[0] = nloc; b.st[1] = nx; }
        const unsigned old = xb_add(&bar[XB_XSUB(b.x)], 1u);
        const unsigned gen = old / nloc;
        if (old + 1u == (gen + 1u) * nloc) {
            __builtin_amdgcn_fence(__ATOMIC_RELEASE, "agent");
            asm volatile("s_waitcnt vmcnt(0)" ::: "memory");
            const unsigned og = xb_add(&bar[XB_TOP], 1u);
            const unsigned tg = og / nx;
            if (og + 1u == (tg + 1u) * nx) xb_add(&bar[XB_TOPGEN], 1u);
            else XB_SPIN(xb_ld(&bar[XB_TOPGEN]) == tg, bar);
            __builtin_amdgcn_fence(__ATOMIC_ACQUIRE, "agent");
            xb_add(&bar[XB_XGEN(b.x)], 1u);
            asm volatile("s_waitcnt vmcnt(0)" ::: "memory");
        } else {
            XB_SPIN(xb_ld(&bar[XB_XGEN(b.x)]) == gen, bar);
            __builtin_amdgcn_fence(__ATOMIC_ACQUIRE, "agent");
            asm volatile("s_waitcnt vmcnt(0)" ::: "memory");
        }
    }
    __syncthreads();
}

constexpr int NTOK = 18432, NP = 16384, DM = 1024, DV = 2048, DFF = 2816;
constexpr float ALPHA = 1.189207115002721f;
constexpr size_t WS_XB = 0;
constexpr size_t WS_WIN = WS_XB + (size_t)NTOK * DM * 2;
constexpr size_t WS_WR = WS_WIN + (size_t)11264 * 1024 * 2;
constexpr size_t WS_WC = WS_WR + (size_t)1024 * 2048 * 2;
constexpr size_t WS_WO = WS_WC + (size_t)1024 * 1024 * 2;
constexpr size_t WS_WUP = WS_WO + (size_t)1024 * 1024 * 2;
constexpr size_t WS_WD = WS_WUP + (size_t)5632 * 1024 * 2;
constexpr size_t WS_ROPE = WS_WD + (size_t)1024 * 2816 * 2;
constexpr size_t WS_SSQ = WS_ROPE + (size_t)2112 * 256 * 4;
constexpr size_t WS_Q = WS_SSQ + (size_t)NTOK * 128 * 4;
constexpr size_t WS_K = WS_Q + (size_t)NTOK * DM * 2;
constexpr size_t WS_V = WS_K + (size_t)NTOK * DM * 2;
constexpr size_t WS_BAR = WS_V + (size_t)NTOK * DV * 2;
constexpr int TAIL_CNT_WORDS = 2560;
constexpr size_t WS_CSLAB = WS_BAR + (size_t)(XCD_BAR_WORDS + TAIL_CNT_WORDS) * 4;
constexpr size_t WS_END = WS_CSLAB + ((size_t)16 << 20);
constexpr size_t OUT_SP = 18874368, OUT_CP = 23068672, OUT_SS = 23085056, OUT_CS = 39862272;

struct Params {
    const float *x_prompt, *x_sample, *state_ret, *cache_conv, *w_in, *w_conv, *w_ret_out, *w_conv_out, *w_o, *ln1_g, *ln1_b, *w_up, *w_down, *ln2_g, *ln2_b;
    float* out; unsigned char* ws; int ph_lo, ph_hi;
};

__device__ __forceinline__ float lg2g(int h) { return h == 0 ? -0.045803689613125f : (h == 1 ? -0.022720076500083f : (h == 2 ? -0.011315313227834f : -0.005646563141142f)); }
__device__ __forceinline__ float fsigmoid(float x) { return __builtin_amdgcn_rcpf(1.0f + __builtin_amdgcn_exp2f(-1.4426950408889634f * x)); }
__device__ __forceinline__ float fsilu(float x) { return x * __builtin_amdgcn_rcpf(1.0f + __builtin_amdgcn_exp2f(-1.4426950408889634f * x)); }
__device__ __forceinline__ float bf2f(unsigned short b) { return __uint_as_float(((unsigned)b) << 16); }
__device__ __forceinline__ float bflo(unsigned w) { return __uint_as_float(w << 16); }
__device__ __forceinline__ float bfhi(unsigned w) { return __uint_as_float(w & 0xffff0000u); }
__device__ __forceinline__ u32x4 pack8(f32x4 a, f32x4 b) { u32x4 w; w.x = cvt_pk_bf16(a[0], a[1]); w.y = cvt_pk_bf16(a[2], a[3]); w.z = cvt_pk_bf16(b[0], b[1]); w.w = cvt_pk_bf16(b[2], b[3]); return w; }
__device__ __forceinline__ void unpack8(u32x4 w, f32x4& a, f32x4& b) { a = (f32x4){bflo(w.x), bfhi(w.x), bflo(w.y), bfhi(w.y)}; b = (f32x4){bflo(w.z), bfhi(w.z), bflo(w.w), bfhi(w.w)}; }

__device__ __forceinline__ int win_col(int nb) {
    const int n = nb * 64;
    if (n < 6144) return n;
    if (n < 10240) { const int w = n - 6144, j = w >> 8, seg = (w >> 6) & 3; const int base = seg == 0 ? 7168 : (seg == 1 ? 6144 : (seg == 2 ? 8192 : 10240)); return base + 64 * j; }
    return 9216 + (n - 10240);
}
__device__ __forceinline__ int wup_col(int nb) { const int pn = nb >> 2, sub = nb & 3; return sub < 2 ? 128 * pn + 64 * sub : 2816 + 128 * pn + 64 * (sub - 2); }

__device__ __forceinline__ void transpose_tile(const float* src, int ld, int k0, int c0, bf16_t* dst, int K, int n0, LAS float* t) {
    const int tid = threadIdx.x;
#pragma unroll
    for (int it = 0; it < 2; ++it) { const int idx = tid + it * 512, kr = idx >> 4, c4 = idx & 15;
        const f32x4 v = __builtin_nontemporal_load((const f32x4*)(src + (size_t)(k0 + kr) * ld + c0 + c4 * 4));
        t[kr * 65 + c4 * 4 + 0] = v[0]; t[kr * 65 + c4 * 4 + 1] = v[1]; t[kr * 65 + c4 * 4 + 2] = v[2]; t[kr * 65 + c4 * 4 + 3] = v[3]; }
    __syncthreads();
    const int n = tid >> 3, kg = tid & 7;
    float f[8];
#pragma unroll
    for (int i = 0; i < 8; ++i) f[i] = t[(kg * 8 + i) * 65 + n];
    u32x4 w; w.x = cvt_pk_bf16(f[0], f[1]); w.y = cvt_pk_bf16(f[2], f[3]); w.z = cvt_pk_bf16(f[4], f[5]); w.w = cvt_pk_bf16(f[6], f[7]);
    *(u32x4*)(dst + (size_t)(n0 + n) * K + k0 + kg * 8) = w;
    __syncthreads();
}

__device__ __forceinline__ void phase_convert(const Params& p, LAS unsigned char* lds, int part) {
    if (part == 0) {
    const size_t gtid = (size_t)blockIdx.x * 512 + threadIdx.x, gsz = (size_t)gridDim.x * 512;
    bf16_t* xb = (bf16_t*)(p.ws + WS_XB);
    for (size_t i = gtid; i < (size_t)NTOK * DM / 8; i += gsz) {
        const size_t e = i * 8; const float* src = e < (size_t)NP * DM ? p.x_prompt + e : p.x_sample + (e - (size_t)NP * DM);
        const f32x4 a = __builtin_nontemporal_load((const f32x4*)src), b = __builtin_nontemporal_load((const f32x4*)(src + 4));
        *(u32x4*)(xb + e) = pack8(a, b);
    }
    float* rope = (float*)(p.ws + WS_ROPE);
    for (size_t i = gtid; i < (size_t)2112 * 128; i += gsz) {
        const int pos = (int)(i >> 7), f = (int)(i & 127);
        const float lin = (float)f * (1.0f / 127.0f);
        const float inv = 1.0f / exp2f(lin * 13.287712379549449f);
        const float ang = (float)pos * inv;
        const double a = (double)ang; const double n = rint(a * 0.15915494309189535); const float r = (float)(a - n * 6.283185307179586);
        rope[(size_t)pos * 256 + f] = __cosf(r); rope[(size_t)pos * 256 + 128 + f] = __sinf(r);
    }
    }
    LAS float* t = (LAS float*)lds;
    constexpr int T_IN = 16 * 176, T_R = 32 * 16, T_C = 16 * 16, T_O = 16 * 16, T_UP = 16 * 88, T_D = 44 * 16;
    constexpr int TT = T_IN + T_R + T_C + T_O + T_UP + T_D;
    const int lo = part == 0 ? 0 : (part == 1 ? 1024 : 4544), hi = part == 0 ? 2752 : (part == 1 ? 2816 : 5952);
    const int w0 = part == 0 ? (int)blockIdx.x : (part == 2 ? (int)blockIdx.x - 192 : (int)blockIdx.x - 128), wstep = part == 0 ? (int)gridDim.x : (part == 2 ? 64 : 128);
    for (int wi = lo + w0; wi < hi; wi += wstep) {
        const int ti = part == 0 ? (wi < 1024 ? wi : wi + 1792) : wi;
        int x = ti;
        if (x < T_IN) { const int nb = x >> 4, kb = x & 15; transpose_tile(p.w_in, 11264, kb * 64, win_col(nb), (bf16_t*)(p.ws + WS_WIN), 1024, nb * 64, t); continue; } x -= T_IN;
        if (x < T_R) { const int nb = x >> 5, kb = x & 31; transpose_tile(p.w_ret_out, 1024, kb * 64, nb * 64, (bf16_t*)(p.ws + WS_WR), 2048, nb * 64, t); continue; } x -= T_R;
        if (x < T_C) { const int nb = x >> 4, kb = x & 15; transpose_tile(p.w_conv_out, 1024, kb * 64, nb * 64, (bf16_t*)(p.ws + WS_WC), 1024, nb * 64, t); continue; } x -= T_C;
        if (x < T_O) { const int nb = x >> 4, kb = x & 15; transpose_tile(p.w_o, 1024, kb * 64, nb * 64, (bf16_t*)(p.ws + WS_WO), 1024, nb * 64, t); continue; } x -= T_O;
        if (x < T_UP) { const int nb = x >> 4, kb = x & 15; transpose_tile(p.w_up, 5632, kb * 64, wup_col(nb), (bf16_t*)(p.ws + WS_WUP), 1024, nb * 64, t); continue; } x -= T_UP;
        { const int nb = x / 44, kb = x % 44; transpose_tile(p.w_down, 1024, kb * 64, nb * 64, (bf16_t*)(p.ws + WS_WD), 2816, nb * 64, t); }
    }
}

__device__ __forceinline__ int row_pos(int r) { return r < NP ? (r & 2047) : 2048 + ((r - NP) & 63); }

struct Epi1a {
    static constexpr bool PERM = true, AFTER_DRAIN = false;
    bf16_t *qb, *kb, *vb; const float* rope;
    __device__ __forceinline__ void operator()(const f32x4 (&acc)[2][2][4][2], const Unit& u, int wr, int wc, int fr, int fq) const {
        const int row0 = u.pm * BM + wr * 64 + fr;
        if (u.pn < 8) {
            const bool isq = u.pn < 4; const int h = u.pn & 3; const float lg = lg2g(h);
            bf16_t* base = (isq ? qb : kb) + h * 256;
            const int d0 = wc * 32 + 8 * fq;
#pragma unroll
            for (int ai = 0; ai < 2; ++ai)
#pragma unroll
                for (int m = 0; m < 4; ++m) {
                    const int r = row0 + ai * HALF + m * 16;
                    const float sc = isq ? __builtin_amdgcn_exp2f(lg * (float)((r & 63) + 1)) : 0.0625f;
                    const float* tc = rope + (size_t)row_pos(r) * 256 + d0;
                    const f32x4 c0 = *(const f32x4*)tc, c1 = *(const f32x4*)(tc + 4), s0 = *(const f32x4*)(tc + 128), s1 = *(const f32x4*)(tc + 132);
                    const f32x4 x1a = acc[ai][0][m][0], x1b = acc[ai][0][m][1], x2a = acc[ai][1][m][0], x2b = acc[ai][1][m][1];
                    const f32x4 o1a = (x1a * c0 - x2a * s0) * sc, o1b = (x1b * c1 - x2b * s1) * sc;
                    const f32x4 o2a = (x1a * s0 + x2a * c0) * sc, o2b = (x1b * s1 + x2b * c1) * sc;
                    bf16_t* rp = base + (size_t)r * 1024 + d0;
                    *(u32x4*)rp = pack8(o1a, o1b); *(u32x4*)(rp + 128) = pack8(o2a, o2b);
                    asm volatile("" ::: "memory");
                }
        } else {
            const int cv = (u.pn - 8) * 256, h = cv >> 9; const float lg = lg2g(h);
#pragma unroll
            for (int ai = 0; ai < 2; ++ai)
#pragma unroll
                for (int m = 0; m < 4; ++m) {
                    const int r = row0 + ai * HALF + m * 16;
                    const float sc = __builtin_amdgcn_exp2f(lg * (float)(63 - (r & 63)));
                    bf16_t* rp = vb + (size_t)r * 2048 + cv + wc * 32 + 8 * fq;
#pragma unroll
                    for (int bj = 0; bj < 2; ++bj) *(u32x4*)(rp + bj * HALF) = pack8(acc[ai][bj][m][0] * sc, acc[ai][bj][m][1] * sc);
                }
        }
    }
};

struct Epi1b {
    static constexpr bool PERM = true, AFTER_DRAIN = false;
    bf16_t *ob, *cbb, *ub, *sgrb, *sgcb; const float* ssq; float* out;
    __device__ __forceinline__ void operator()(const f32x4 (&acc)[2][2][4][2], const Unit& u, int wr, int wc, int fr, int fq) const {
        const int row0 = u.pm * BM + wr * 64 + fr;
        if (u.pn < 8) {
            const int h = u.pn >> 1, col = u.pn * 256 + wc * 32 + 8 * fq;
#pragma unroll
            for (int ai = 0; ai < 2; ++ai) {
                u32x4 ov[4][2]; f32x4 t4[4];
#pragma unroll
                for (int m = 0; m < 4; ++m) {
                    const int r = row0 + ai * HALF + m * 16;
                    const f32x4* sp = (const f32x4*)(ssq + (size_t)r * 128 + h * 32);
                    t4[m] = ((sp[0] + sp[1]) + (sp[2] + sp[3])) + ((sp[4] + sp[5]) + (sp[6] + sp[7]));
                    const bf16_t* rp = ob + (size_t)r * 2048 + col;
                    ov[m][0] = *(const u32x4*)rp; ov[m][1] = *(const u32x4*)(rp + HALF);
                }
#pragma unroll
                for (int m = 0; m < 4; ++m) {
                    const int r = row0 + ai * HALF + m * 16;
                    const float rstd = rsqrtf(((t4[m][0] + t4[m][1]) + (t4[m][2] + t4[m][3])) * (1.0f / 512.0f) + 1e-6f);
                    bf16_t* rp = ob + (size_t)r * 2048 + col;
#pragma unroll
                    for (int bj = 0; bj < 2; ++bj) {
                        f32x4 oa, obv; unpack8(ov[m][bj], oa, obv);
                        f32x4 ga = acc[ai][bj][m][0], gb = acc[ai][bj][m][1];
#pragma unroll
                        for (int j = 0; j < 4; ++j) { ga[j] = fsilu(ga[j]) * oa[j] * rstd; gb[j] = fsilu(gb[j]) * obv[j] * rstd; }
                        *(u32x4*)(rp + bj * HALF) = pack8(ga, gb);
                    }
                }
            }
        } else if (u.pn < 24) {
            const int j64 = (u.pn - 8) * 64;
            if (wc < 2) {
                const int col = j64 + wc * 32 + 8 * fq;
#pragma unroll
                for (int ai = 0; ai < 2; ++ai)
#pragma unroll
                    for (int m = 0; m < 4; ++m) {
                        const int r = row0 + ai * HALF + m * 16;
                        const f32x4 ua = acc[ai][0][m][0] * acc[ai][1][m][0], uv = acc[ai][0][m][1] * acc[ai][1][m][1];
                        *(u32x4*)(ub + (size_t)r * 1024 + col) = pack8(ua, uv);
                        if (r < NP) { const int pos = r & 2047; if (pos >= 2046) { float* cp = out + OUT_CP + ((size_t)(r >> 11) * 2 + (pos - 2046)) * 1024 + col; *(f32x4*)cp = ua; *(f32x4*)(cp + 4) = uv; } }
                        else { const int s = r - NP, pos = s & 63; if (pos >= 62) { float* cp = out + OUT_CS + ((size_t)(s >> 6) * 2 + (pos - 62)) * 1024 + col; *(f32x4*)cp = ua; *(f32x4*)(cp + 4) = uv; } }
                    }
            } else {
                const int col = j64 + (wc - 2) * 32 + 8 * fq;
#pragma unroll
                for (int ai = 0; ai < 2; ++ai)
#pragma unroll
                    for (int m = 0; m < 4; ++m) {
                        const int r = row0 + ai * HALF + m * 16;
                        *(u32x4*)(cbb + (size_t)r * 1024 + col) = pack8(acc[ai][0][m][0], acc[ai][0][m][1]);
                        f32x4 ga = acc[ai][1][m][0], gb = acc[ai][1][m][1];
#pragma unroll
                        for (int j = 0; j < 4; ++j) { ga[j] = fsigmoid(ga[j]); gb[j] = fsigmoid(gb[j]); }
                        *(u32x4*)(sgcb + (size_t)r * 1024 + col) = pack8(ga, gb);
                    }
            }
        } else {
            const int col = (u.pn - 24) * 256 + wc * 32 + 8 * fq;
#pragma unroll
            for (int ai = 0; ai < 2; ++ai)
#pragma unroll
                for (int m = 0; m < 4; ++m) {
                    const int r = row0 + ai * HALF + m * 16;
#pragma unroll
                    for (int bj = 0; bj < 2; ++bj) {
                        f32x4 ga = acc[ai][bj][m][0], gb = acc[ai][bj][m][1];
#pragma unroll
                        for (int j = 0; j < 4; ++j) { ga[j] = fsigmoid(ga[j]); gb[j] = fsigmoid(gb[j]); }
                        *(u32x4*)(sgrb + (size_t)r * 1024 + col + bj * HALF) = pack8(ga, gb);
                    }
                }
        }
    }
};

template <int SECOND> struct EpiMerge {
    static constexpr bool PERM = true, AFTER_DRAIN = false;
    bf16_t* mb; const bf16_t* gate; unsigned selmask;
    __device__ __forceinline__ void operator()(const f32x4 (&acc)[2][2][4][2], const Unit& u, int wr, int wc, int fr, int fq) const {
        const int row0 = u.pm * BM + wr * 64 + fr, col = u.pn * BM + wc * 32 + 8 * fq;
#pragma unroll
        for (int ai = 0; ai < 2; ++ai) {
            u32x4 gv[4][2], pv[4][2];
#pragma unroll
            for (int m = 0; m < 4; ++m) {
                if (!((selmask >> (ai * 4 + m)) & 1u)) continue;
                const size_t off = (size_t)(row0 + ai * HALF + m * 16) * 1024 + col;
#pragma unroll
                for (int bj = 0; bj < 2; ++bj) { gv[m][bj] = *(const u32x4*)(gate + off + bj * HALF); if (SECOND) pv[m][bj] = *(const u32x4*)(mb + off + bj * HALF); }
            }
#pragma unroll
            for (int m = 0; m < 4; ++m) {
                if (!((selmask >> (ai * 4 + m)) & 1u)) continue;
                const size_t off = (size_t)(row0 + ai * HALF + m * 16) * 1024 + col;
#pragma unroll
                for (int bj = 0; bj < 2; ++bj) {
                    f32x4 ga, gb; unpack8(gv[m][bj], ga, gb);
                    f32x4 va = acc[ai][bj][m][0] * ga, vb = acc[ai][bj][m][1] * gb;
                    if (SECOND) { f32x4 pa, pb; unpack8(pv[m][bj], pa, pb); va += pa; vb += pb; }
                    *(u32x4*)(mb + off + bj * HALF) = pack8(va, vb);
                }
            }
        }
    }
};

struct EpiRes {
    static constexpr bool PERM = false, AFTER_DRAIN = false;
    const float* base_p; const float* base_s; float* o; unsigned selmask;
    __device__ __forceinline__ void operator()(const f32x4 (&acc)[2][2][4][2], const Unit& u, int wr, int wc, int fr, int fq) const {
        const int row0 = u.pm * BM + wr * 64 + fr, col0 = u.pn * BM + wc * 32 + 4 * fq;
#pragma unroll
        for (int ai = 0; ai < 2; ++ai)
#pragma unroll
            for (int mp = 0; mp < 2; ++mp) {
                f32x4 bs[2][2][2];
#pragma unroll
                for (int mm = 0; mm < 2; ++mm) { const int m = 2 * mp + mm;
                    if (!((selmask >> (ai * 4 + m)) & 1u)) continue;
                    const int r = row0 + ai * HALF + m * 16;
                    const float* bp = (r < NP ? base_p + (size_t)r * 1024 : base_s + (size_t)(r - NP) * 1024) + col0;
#pragma unroll
                    for (int bj = 0; bj < 2; ++bj)
#pragma unroll
                        for (int n = 0; n < 2; ++n) bs[mm][bj][n] = *(const f32x4*)(bp + bj * HALF + n * 16); }
#pragma unroll
                for (int mm = 0; mm < 2; ++mm) { const int m = 2 * mp + mm;
                    if (!((selmask >> (ai * 4 + m)) & 1u)) continue;
                    float* op = o + (size_t)(row0 + ai * HALF + m * 16) * 1024 + col0;
#pragma unroll
                    for (int bj = 0; bj < 2; ++bj)
#pragma unroll
                        for (int n = 0; n < 2; ++n) *(f32x4*)(op + bj * HALF + n * 16) = bs[mm][bj][n] * ALPHA + acc[ai][bj][m][n]; }
            }
    }
};

struct EpiResLn {
    static constexpr bool PERM = false, AFTER_DRAIN = false;
    float* o; const float* g; const float* b; const float* stats; unsigned selmask;
    __device__ __forceinline__ void operator()(const f32x4 (&acc)[2][2][4][2], const Unit& u, int wr, int wc, int fr, int fq) const {
        const int row0 = u.pm * BM + wr * 64 + fr, col0 = u.pn * BM + wc * 32 + 4 * fq;
        f32x4 gv[2][2], bv[2][2];
#pragma unroll
        for (int bj = 0; bj < 2; ++bj)
#pragma unroll
            for (int n = 0; n < 2; ++n) { gv[bj][n] = *(const f32x4*)(g + col0 + bj * HALF + n * 16) * ALPHA; bv[bj][n] = *(const f32x4*)(b + col0 + bj * HALF + n * 16) * ALPHA; }
#pragma unroll
        for (int ai = 0; ai < 2; ++ai)
#pragma unroll
            for (int mp = 0; mp < 2; ++mp) {
                f32x4 hp[2][2][2]; float mu[2], rs[2];
#pragma unroll
                for (int mm = 0; mm < 2; ++mm) { const int m = 2 * mp + mm;
                    if (!((selmask >> (ai * 4 + m)) & 1u)) continue;
                    const int r = row0 + ai * HALF + m * 16;
                    mu[mm] = stats[2 * r]; rs[mm] = stats[2 * r + 1];
                    const float* op = o + (size_t)r * 1024 + col0;
#pragma unroll
                    for (int bj = 0; bj < 2; ++bj)
#pragma unroll
                        for (int n = 0; n < 2; ++n) hp[mm][bj][n] = *(const f32x4*)(op + bj * HALF + n * 16); }
#pragma unroll
                for (int mm = 0; mm < 2; ++mm) { const int m = 2 * mp + mm;
                    if (!((selmask >> (ai * 4 + m)) & 1u)) continue;
                    float* op = o + (size_t)(row0 + ai * HALF + m * 16) * 1024 + col0;
#pragma unroll
                    for (int bj = 0; bj < 2; ++bj)
#pragma unroll
                        for (int n = 0; n < 2; ++n) *(f32x4*)(op + bj * HALF + n * 16) = ((hp[mm][bj][n] - mu[mm]) * rs[mm]) * gv[bj][n] + bv[bj][n] + acc[ai][bj][m][n]; }
            }
    }
};

struct EpiUp {
    static constexpr bool PERM = true, AFTER_DRAIN = false;
    bf16_t* fb;
    __device__ __forceinline__ void operator()(const f32x4 (&acc)[2][2][4][2], const Unit& u, int wr, int wc, int fr, int fq) const {
        const int row0 = u.pm * BM + wr * 64 + fr, col = u.pn * 128 + wc * 32 + 8 * fq;
#pragma unroll
        for (int ai = 0; ai < 2; ++ai)
#pragma unroll
            for (int m = 0; m < 4; ++m) {
                f32x4 va = acc[ai][0][m][0], vb = acc[ai][0][m][1];
#pragma unroll
                for (int j = 0; j < 4; ++j) { va[j] = fsilu(va[j]) * acc[ai][1][m][0][j]; vb[j] = fsilu(vb[j]) * acc[ai][1][m][1][j]; }
                *(u32x4*)(fb + (size_t)(row0 + ai * HALF + m * 16) * DFF + col) = pack8(va, vb);
            }
    }
};

__device__ __forceinline__ bf16x8 mk8(s16x4 lo, s16x4 hi) { return __builtin_shufflevector(lo, hi, 0, 1, 2, 3, 4, 5, 6, 7); }
__device__ __forceinline__ int offQK(int row, int cb) { return row * 576 + (cb ^ (((row >> 3) & 1) << 5)); }
__device__ __forceinline__ int offV(int row, int cb) { return row * 192 + (cb ^ (((row >> 3) & 1) << 5)); }
__device__ __forceinline__ int offS(int row, int cb) { return row * 192 + (cb ^ (((row >> 1) & 7) << 3)); }
template <int IMG> __device__ __forceinline__ bf16x8 trfrag(LAS unsigned char* img, int krow0, int col0, int lane) {
    const int g = lane >> 4, q = (lane & 15) >> 2, pp = lane & 3, row = krow0 + 8 * g + q, cb = (col0 + 4 * pp) * 2;
    const int a0 = IMG == 0 ? offQK(row, cb) : (IMG == 1 ? offV(row, cb) : offS(row, cb));
    const int a1 = IMG == 0 ? offQK(row + 4, cb) : (IMG == 1 ? offV(row + 4, cb) : offS(row + 4, cb));
    const s16x4 lo = __builtin_amdgcn_ds_read_tr16_b64_v4i16((LAS s16x4*)(img + a0));
    const s16x4 hi = __builtin_amdgcn_ds_read_tr16_b64_v4i16((LAS s16x4*)(img + a1));
    return mk8(lo, hi);
}
#define MFMA16(a, b, c) __builtin_amdgcn_mfma_f32_16x16x32_bf16((a), (b), (c), 0, 0, 0)

#define LDS_BARRIER() do { asm volatile("s_waitcnt lgkmcnt(0)" ::: "memory"); __builtin_amdgcn_s_barrier(); asm volatile("" ::: "memory"); } while (0)
struct RItem { int h, es; size_t row0; const float* S0; float* Sout; };
__device__ __forceinline__ RItem ret_prompt_item(const Params& p, int item) {
    const int xcd = item & 7, idx = item >> 3, bh = xcd * 4 + (idx >> 3), es = idx & 7, b = bh >> 2, h = bh & 3;
    return RItem{h, es, (size_t)b * 2048, nullptr, p.out + OUT_SP + ((size_t)(b * 4 + h) * 256) * 512 + es * 64};
}
__device__ __forceinline__ RItem ret_sample_item(const Params& p, int s) {
    const int xcd = s & 7, idx = s >> 3, bh = xcd * 16 + (idx >> 3), es = idx & 7, b = bh >> 2, h = bh & 3;
    return RItem{h, es, (size_t)NP + (size_t)b * 64, p.state_ret + ((size_t)(b * 4 + h) * 256) * 512 + es * 64, p.out + OUT_SS + ((size_t)(b * 4 + h) * 256) * 512 + es * 64};
}
__device__ __forceinline__ void phase_retention(const Params& p, LAS unsigned char* lds) {
    int tid_ = threadIdx.x; asm volatile("" : "+v"(tid_));
    const int tid = tid_, wid = __builtin_amdgcn_readfirstlane(tid >> 6), lane = tid & 63, fr = lane & 15, fq = lane >> 4, q4 = (lane & 15) >> 2, pp = lane & 3;
    constexpr int OFF_Q = 0, OFF_K = 36864, OFF_V = 73728, OFF_P = 86016, OFF_S = 96256;
    const bf16_t* qb = (const bf16_t*)(p.ws + WS_Q); const bf16_t* kb = (const bf16_t*)(p.ws + WS_K); const bf16_t* vb = (const bf16_t*)(p.ws + WS_V);
    bf16_t* ob = (bf16_t*)p.out; float* ssq = (float*)(p.ws + WS_SSQ);
    const int lrow = tid >> 3, piece = tid & 7;
    const int ip = wid & 1, hw = wid >> 1;
    const int bid = (int)blockIdx.x;
    const int rQ0 = 32 * ip + fr, rQ1 = rQ0 + 16, rK = 16 * hw + fr, trr = 8 * fq + q4, gb = fq & 1;
    const int aq0 = OFF_Q + rQ0 * 576 + ((fq * 16) ^ (((rQ0 >> 3) & 1) << 5)), aq1 = OFF_Q + rQ1 * 576 + ((fq * 16) ^ (((rQ1 >> 3) & 1) << 5));
    const int ak1 = OFF_K + rK * 576 + ((fq * 16) ^ (((rK >> 3) & 1) << 5));
    const int ap0 = OFF_P + rQ0 * 160 + fq * 16, ap1 = ap0 + 16 * 160;
    const int apw0 = OFF_P + rQ0 * 160 + (16 * hw + 4 * fq) * 2, apw1 = apw0 + 16 * 160;
    const int av2 = OFF_V + trr * 192 + (((16 * hw + 4 * pp) * 2) ^ (gb << 5));
    const int as20 = OFF_S + trr * 192 + (((16 * hw + 4 * pp) * 2) ^ (((trr >> 1) & 7) << 3));
    const int as21 = OFF_S + (trr + 4) * 192 + (((16 * hw + 4 * pp) * 2) ^ ((((trr + 4) >> 1) & 7) << 3));
    const int ak30 = OFF_K + trr * 576 + 64 * wid + 8 * pp + 32 * (0 ^ gb), ak31 = OFF_K + trr * 576 + 64 * wid + 8 * pp + 32 * (1 ^ gb);
    const int av30 = OFF_V + trr * 192 + 8 * pp + 32 * (0 ^ gb), av31 = OFF_V + trr * 192 + 8 * pp + 32 * (1 ^ gb);
    const int swl = ((lrow >> 3) & 1) << 5;
    const int awq = OFF_Q + lrow * 576 + ((piece * 16) ^ swl), awv = OFF_V + lrow * 192 + ((piece * 16) ^ swl);
    const int asw0 = OFF_S + (32 * wid + fr) * 192 + ((8 * fq) ^ (((fr >> 1) & 7) << 3)), asw1 = OFF_S + (32 * wid + fr) * 192 + ((32 + 8 * fq) ^ (((fr >> 1) & 7) << 3));
#define RD128(a) (*(const LAS bf16x8*)(lds + (a)))
#define RDTR(a) __builtin_amdgcn_ds_read_tr16_b64_v4i16((LAS s16x4*)(lds + (a)))
#define RET_LOAD_S(S, src) do { _Pragma("unroll") for (int et = 0; et < 4; ++et) _Pragma("unroll") for (int dt = 0; dt < 2; ++dt) \
        S[et][dt] = __builtin_nontemporal_load((const f32x4*)((src) + (size_t)(32 * wid + 16 * dt + fr) * 512 + 16 * et + 4 * fq)); } while (0)
#define RET_WRITE_SLDS(S) do { _Pragma("unroll") for (int et = 0; et < 4; ++et) _Pragma("unroll") for (int dt = 0; dt < 2; ++dt) { \
        u32x2 w_; w_.x = cvt_pk_bf16(S[et][dt][0], S[et][dt][1]); w_.y = cvt_pk_bf16(S[et][dt][2], S[et][dt][3]); \
        *(LAS u32x2*)(lds + ((et & 1) ? asw1 : asw0) + 64 * (et >> 1) + dt * 3072) = w_; } } while (0)
#define RET_STORE_S(S, dst) do { _Pragma("unroll") for (int et = 0; et < 4; ++et) _Pragma("unroll") for (int dt = 0; dt < 2; ++dt) \
        __builtin_nontemporal_store(S[et][dt], (f32x4*)((dst) + (size_t)(32 * wid + 16 * dt + fr) * 512 + 16 * et + 4 * fq)); } while (0)
    auto load_chunk = [&](size_t rowb, int h, int es, u32x4 (&pq)[4], u32x4 (&pk)[4], u32x4& pv) __attribute__((always_inline)) {
        const size_t r = rowb + lrow;
#pragma unroll
        for (int it = 0; it < 4; ++it) { pq[it] = *(const u32x4*)(qb + r * 1024 + h * 256 + (piece + 8 * it) * 8); pk[it] = *(const u32x4*)(kb + r * 1024 + h * 256 + (piece + 8 * it) * 8); }
        pv = __builtin_nontemporal_load((const u32x4*)(vb + r * 2048 + h * 512 + es * 64 + piece * 8));
    };
    auto write_chunk = [&](const u32x4 (&pq)[4], const u32x4 (&pk)[4], const u32x4& pv) __attribute__((always_inline)) {
#pragma unroll
        for (int it = 0; it < 4; ++it) { *(LAS u32x4*)(lds + awq + it * 128) = pq[it]; *(LAS u32x4*)(lds + awq + 36864 + it * 128) = pk[it]; }
        *(LAS u32x4*)(lds + awv) = pv;
    };
    auto compute = [&](f32x4 (&S)[4][2], int h, int es, size_t rowb) __attribute__((always_inline)) {
        const float lg = lg2g(h), carry = exp2f(64.0f * lg);
        {   f32x4 sacc0 = {0.f, 0.f, 0.f, 0.f}, sacc1 = {0.f, 0.f, 0.f, 0.f};
#pragma unroll
            for (int kk = 0; kk < 8; ++kk) { const bf16x8 kf = RD128(ak1 + kk * 64); sacc0 = MFMA16(kf, RD128(aq0 + kk * 64), sacc0); sacc1 = MFMA16(kf, RD128(aq1 + kk * 64), sacc1); }
            const int j0 = 16 * hw + 4 * fq;
#pragma unroll
            for (int u = 0; u < 2; ++u) { const int i = rQ0 + 16 * u; const f32x4 sa = u ? sacc1 : sacc0; float v[4];
#pragma unroll
                for (int jj = 0; jj < 4; ++jj) { const int j = j0 + jj; const int ex = (j <= i) ? -64 : 2 * (j - i) - 64; v[jj] = sa[jj] * __builtin_amdgcn_exp2f(lg * (float)ex); }
                u32x2 w; w.x = cvt_pk_bf16(v[0], v[1]); w.y = cvt_pk_bf16(v[2], v[3]);
                *(LAS u32x2*)(lds + (u ? apw1 : apw0)) = w; }
        }
        LDS_BARRIER();
        {   f32x4 oacc0 = {0.f, 0.f, 0.f, 0.f}, oacc1 = {0.f, 0.f, 0.f, 0.f};
#pragma unroll
            for (int kk = 0; kk < 2; ++kk) { const bf16x8 vf = mk8(RDTR(av2 + kk * 6144), RDTR(av2 + kk * 6144 + 768)); oacc0 = MFMA16(vf, RD128(ap0 + kk * 64), oacc0); oacc1 = MFMA16(vf, RD128(ap1 + kk * 64), oacc1); }
#pragma unroll
            for (int kk = 0; kk < 8; ++kk) { const bf16x8 sf = mk8(RDTR(as20 + kk * 6144), RDTR(as21 + kk * 6144)); oacc0 = MFMA16(sf, RD128(aq0 + kk * 64), oacc0); oacc1 = MFMA16(sf, RD128(aq1 + kk * 64), oacc1); }
#pragma unroll
            for (int u = 0; u < 2; ++u) { const size_t r = rowb + rQ0 + 16 * u; const f32x4 o = u ? oacc1 : oacc0;
                float ss = (o[0] * o[0] + o[1] * o[1]) + (o[2] * o[2] + o[3] * o[3]);
                u32x2 w; w.x = cvt_pk_bf16(o[0], o[1]); w.y = cvt_pk_bf16(o[2], o[3]);
                *(u32x2*)(ob + r * 2048 + h * 512 + es * 64 + 16 * hw + 4 * fq) = w;
                ss += __shfl_xor(ss, 16); ss += __shfl_xor(ss, 32);
                if (fq == 0) ssq[r * 128 + h * 32 + es * 4 + hw] = ss; }
        }
#pragma unroll
        for (int et = 0; et < 4; ++et)
#pragma unroll
            for (int dt = 0; dt < 2; ++dt) S[et][dt] *= carry;
#pragma unroll
        for (int kk = 0; kk < 2; ++kk) {
            const bf16x8 kf0 = mk8(RDTR(ak30 + kk * 18432), RDTR(ak30 + kk * 18432 + 2304)), kf1 = mk8(RDTR(ak31 + kk * 18432), RDTR(ak31 + kk * 18432 + 2304));
#pragma unroll
            for (int et = 0; et < 4; ++et) { const int av = ((et & 1) ? av31 : av30) + 64 * (et >> 1) + kk * 6144; const bf16x8 vf = mk8(RDTR(av), RDTR(av + 768));
                S[et][0] = MFMA16(vf, kf0, S[et][0]); S[et][1] = MFMA16(vf, kf1, S[et][1]); }
        }
        LDS_BARRIER();
    };
    {   const RItem C = ret_prompt_item(p, bid);
        f32x4 Sc[4][2];
#pragma unroll
        for (int et = 0; et < 4; ++et)
#pragma unroll
            for (int dt = 0; dt < 2; ++dt) Sc[et][dt] = (f32x4){0.f, 0.f, 0.f, 0.f};
        u32x4 pqA[4], pkA[4], pvA, pqB[4], pkB[4], pvB;
        load_chunk(C.row0, C.h, C.es, pqA, pkA, pvA);
        load_chunk(C.row0 + 64, C.h, C.es, pqB, pkB, pvB);
        RET_WRITE_SLDS(Sc);
        for (int step = 0; step < 32; step += 2) {
            write_chunk(pqA, pkA, pvA); LDS_BARRIER();
            if (step + 2 < 32) load_chunk(C.row0 + (size_t)(step + 2) * 64, C.h, C.es, pqA, pkA, pvA);
            compute(Sc, C.h, C.es, C.row0 + (size_t)step * 64);
            RET_WRITE_SLDS(Sc);
            write_chunk(pqB, pkB, pvB); LDS_BARRIER();
            if (step + 3 < 32) load_chunk(C.row0 + (size_t)(step + 3) * 64, C.h, C.es, pqB, pkB, pvB);
            compute(Sc, C.h, C.es, C.row0 + (size_t)(step + 1) * 64);
            if (step + 2 < 32) RET_WRITE_SLDS(Sc);
        }
        RET_STORE_S(Sc, C.Sout);
    }
    {   RItem X = ret_sample_item(p, bid);
        f32x4 Sx[4][2], Sn[4][2]; u32x4 pq[4], pk[4], pv;
        RET_LOAD_S(Sx, X.S0); load_chunk(X.row0, X.h, X.es, pq, pk, pv);
        for (int k = 0; k < 4; ++k) {
            RET_WRITE_SLDS(Sx); write_chunk(pq, pk, pv); LDS_BARRIER();
            const RItem Y = ret_sample_item(p, bid + 256 * (k < 3 ? k + 1 : k));
            if (k < 3) { RET_LOAD_S(Sn, Y.S0); load_chunk(Y.row0, Y.h, Y.es, pq, pk, pv); }
            compute(Sx, X.h, X.es, X.row0);
            RET_STORE_S(Sx, X.Sout);
            if (k < 3) {
#pragma unroll
                for (int et = 0; et < 4; ++et)
#pragma unroll
                    for (int dt = 0; dt < 2; ++dt) Sx[et][dt] = Sn[et][dt];
                X = Y; }
        }
    }
#undef RD128
#undef RDTR
#undef RET_LOAD_S
#undef RET_WRITE_SLDS
#undef RET_STORE_S
}

__device__ __forceinline__ void phase_conv(const Params& p) {
    const size_t gtid = (size_t)blockIdx.x * 512 + threadIdx.x, gsz = (size_t)gridDim.x * 512;
    bf16_t* cbb = (bf16_t*)(p.ws + WS_Q); const bf16_t* ub = (const bf16_t*)(p.ws + WS_K);
    for (size_t idx = gtid; idx < (size_t)(NTOK / 4) * 128; idx += gsz) {
        const int r0 = (int)(idx >> 7) * 4, c = (int)(idx & 127) * 8;
        const bool smp = r0 >= NP; const int pos0 = smp ? ((r0 - NP) & 63) : (r0 & 2047);
        u32x4 uw[6], cw[4];
#pragma unroll
        for (int j = 0; j < 6; ++j) if (j >= 2 || pos0 >= 2) uw[j] = __builtin_nontemporal_load((const u32x4*)(ub + (size_t)(r0 - 2 + j) * 1024 + c));
#pragma unroll
        for (int j = 0; j < 4; ++j) cw[j] = __builtin_nontemporal_load((const u32x4*)(cbb + (size_t)(r0 + j) * 1024 + c));
        const f32x4 w0a = *(const f32x4*)(p.w_conv + c), w0b = *(const f32x4*)(p.w_conv + c + 4);
        const f32x4 w1a = *(const f32x4*)(p.w_conv + 1024 + c), w1b = *(const f32x4*)(p.w_conv + 1024 + c + 4);
        const f32x4 w2a = *(const f32x4*)(p.w_conv + 2048 + c), w2b = *(const f32x4*)(p.w_conv + 2048 + c + 4);
        f32x4 ua[6], uv[6];
#pragma unroll
        for (int j = 2; j < 6; ++j) unpack8(uw[j], ua[j], uv[j]);
        if (pos0 >= 2) { unpack8(uw[0], ua[0], uv[0]); unpack8(uw[1], ua[1], uv[1]); }
        else if (smp) { const float* cache = p.cache_conv + (size_t)((r0 - NP) >> 6) * 2048 + c;
            ua[0] = *(const f32x4*)cache; uv[0] = *(const f32x4*)(cache + 4); ua[1] = *(const f32x4*)(cache + 1024); uv[1] = *(const f32x4*)(cache + 1024 + 4); }
        else { ua[0] = (f32x4){0.f, 0.f, 0.f, 0.f}; uv[0] = ua[0]; ua[1] = ua[0]; uv[1] = ua[0]; }
#pragma unroll
        for (int j = 0; j < 4; ++j) {
            f32x4 ca, cbv; unpack8(cw[j], ca, cbv);
            const f32x4 ra = ca * (w0a * ua[j] + w1a * ua[j + 1] + w2a * ua[j + 2]), rb = cbv * (w0b * uv[j] + w1b * uv[j + 1] + w2b * uv[j + 2]);
            *(u32x4*)(cbb + (size_t)(r0 + j) * 1024 + c) = pack8(ra, rb);
        }
    }
}

__device__ __forceinline__ void phase_ln(float* x, const float* g, const float* bta, bf16_t* xb, float* stats = nullptr) {
    const int lane = threadIdx.x & 63, wv = (blockIdx.x * 512 + threadIdx.x) >> 6, nwv = gridDim.x * 8;
    f32x4 gg[4], bb[4];
#pragma unroll
    for (int i = 0; i < 4; ++i) { gg[i] = *(const f32x4*)(g + i * 256 + lane * 4); bb[i] = *(const f32x4*)(bta + i * 256 + lane * 4); }
    for (int r0 = wv; r0 < NTOK; r0 += 3 * nwv) {
        f32x4 v[3][4];
#pragma unroll
        for (int j = 0; j < 3; ++j) { const int r = r0 + j * nwv; if (r < NTOK) {
#pragma unroll
            for (int i = 0; i < 4; ++i) v[j][i] = __builtin_nontemporal_load((const f32x4*)(x + (size_t)r * 1024 + lane * 4 + i * 256)); } }
#pragma unroll
        for (int j = 0; j < 3; ++j) { const int r = r0 + j * nwv; if (r < NTOK) {
            float* rp = x + (size_t)r * 1024 + lane * 4; float s = 0.f;
#pragma unroll
            for (int i = 0; i < 4; ++i) s += (v[j][i][0] + v[j][i][1]) + (v[j][i][2] + v[j][i][3]);
#pragma unroll
            for (int o = 32; o >= 1; o >>= 1) s += __shfl_xor(s, o);
            const float mu = s * (1.0f / 1024.0f); float q = 0.f;
#pragma unroll
            for (int i = 0; i < 4; ++i) { v[j][i] -= mu; q += (v[j][i][0] * v[j][i][0] + v[j][i][1] * v[j][i][1]) + (v[j][i][2] * v[j][i][2] + v[j][i][3] * v[j][i][3]); }
#pragma unroll
            for (int o = 32; o >= 1; o >>= 1) q += __shfl_xor(q, o);
            const float rstd = rsqrtf(q * (1.0f / 1024.0f) + 1e-5f);
            if (stats && lane == 0) { stats[2 * r] = mu; stats[2 * r + 1] = rstd; }
#pragma unroll
            for (int i = 0; i < 4; ++i) { const f32x4 y = v[j][i] * rstd * gg[i] + bb[i]; if (!stats) __builtin_nontemporal_store(y, (f32x4*)(rp + i * 256));
                if (xb) { u32x2 w; w.x = cvt_pk_bf16(y[0], y[1]); w.y = cvt_pk_bf16(y[2], y[3]); *(u32x2*)(xb + (size_t)r * 1024 + i * 256 + lane * 4) = w; } }
        } }
    }
}

template <class Epi> __device__ __forceinline__ void run_gemm(LAS unsigned char* lds, Gemm g, Epi E) {
    StaticOrder S; S.init(g.M, g.N, (int)gridDim.x, (int)blockIdx.x); gemm_phase<Epi, StaticOrder>(lds, g, S, E, nullptr);
}
template <class Epi> __device__ __forceinline__ void run_gemm_head(LAS unsigned char* lds, Gemm g, Epi E) {
    RangeOrder S; S.init(g.M, g.N, (int)gridDim.x, (int)blockIdx.x); S.imax = 1; gemm_phase<Epi, RangeOrder>(lds, g, S, E, nullptr);
}
__device__ __forceinline__ void tile_sync(unsigned* cnt, unsigned want) {
    asm volatile("s_waitcnt vmcnt(0)" ::: "memory");
    __syncthreads();
    if (threadIdx.x == 0) {
        __hip_atomic_fetch_add(cnt, 1u, __ATOMIC_RELAXED, __HIP_MEMORY_SCOPE_AGENT);
        while (__hip_atomic_load(cnt, __ATOMIC_RELAXED, __HIP_MEMORY_SCOPE_AGENT) < want) __builtin_amdgcn_s_sleep(1);
        __builtin_amdgcn_fence(__ATOMIC_ACQUIRE, "agent");
        asm volatile("s_waitcnt vmcnt(0)" ::: "memory");
    }
    asm volatile("" ::: "memory");
    __syncthreads();
    asm volatile("" ::: "memory");
}
template <int NSL> __device__ __forceinline__ void slab_sum(const float* tile_slabs, int s, f32x4 (&out)[2][2][2]) {
    const unsigned long long* sp = (const unsigned long long*)tile_slabs + threadIdx.x;
#pragma unroll
    for (int c = 0; c < 2; ++c)
#pragma unroll
        for (int bj = 0; bj < 2; ++bj)
#pragma unroll
            for (int n = 0; n < 2; ++n) { const int idx = (((2 * s + c) * 2 + bj) * 2 + n) * 2;
                f32x4 v = {0.f, 0.f, 0.f, 0.f};
#pragma unroll
                for (int sl = 0; sl < NSL; ++sl) {
                    const unsigned long long lo = __hip_atomic_load(sp + (size_t)sl * 32768 + (size_t)idx * 512, __ATOMIC_RELAXED, __HIP_MEMORY_SCOPE_AGENT);
                    const unsigned long long hi = __hip_atomic_load(sp + (size_t)sl * 32768 + (size_t)(idx + 1) * 512, __ATOMIC_RELAXED, __HIP_MEMORY_SCOPE_AGENT);
                    v[0] += __uint_as_float((unsigned)lo); v[1] += __uint_as_float((unsigned)(lo >> 32)); v[2] += __uint_as_float((unsigned)hi); v[3] += __uint_as_float((unsigned)(hi >> 32)); }
                out[c][bj][n] = v; }
}
__device__ __forceinline__ void merge_tails(LAS unsigned char* lds, Gemm gr, Gemm gc, bf16_t* mb, const bf16_t* sgr, const bf16_t* sgc, float* rslabs, float* cslabs, unsigned* rcnt, unsigned* ccnt) {
    const int b = (int)blockIdx.x; if (b >= 192) return;
    const bool isr = b < 128; const int tile = isr ? (b >> 2) : ((b - 128) >> 1), s = isr ? (b & 3) : (b & 1);
    StaticOrder T; T.init(gr.M, gr.N, (int)gridDim.x, 0); T.c = (int)gridDim.x + tile; OneUnit S; T.next(0, S.u0);
    Gemm gs = isr ? gr : gc; gs.ld = gs.K; gs.A += s * 512; gs.Bt += s * 512; gs.K = 512;
    EpiSlab<true> ES{isr ? rslabs + (size_t)(tile * 4 + s) * 65536 : cslabs + (size_t)(tile * 2 + s) * 65536};
    gemm_phase<EpiSlab<true>, OneUnit>(lds, gs, S, ES, nullptr);
    asm volatile("s_waitcnt vmcnt(0)" ::: "memory");
    __syncthreads();
    if (threadIdx.x == 0) {
        __hip_atomic_fetch_add((isr ? rcnt : ccnt) + tile * 16, 1u, __ATOMIC_RELAXED, __HIP_MEMORY_SCOPE_AGENT);
        if (isr) {
            while (__hip_atomic_load(rcnt + tile * 16, __ATOMIC_RELAXED, __HIP_MEMORY_SCOPE_AGENT) < 4u) __builtin_amdgcn_s_sleep(1);
            while (__hip_atomic_load(ccnt + tile * 16, __ATOMIC_RELAXED, __HIP_MEMORY_SCOPE_AGENT) < 2u) __builtin_amdgcn_s_sleep(1);
            __builtin_amdgcn_fence(__ATOMIC_ACQUIRE, "agent");
            asm volatile("s_waitcnt vmcnt(0)" ::: "memory");
        }
    }
    asm volatile("" ::: "memory");
    __syncthreads();
    asm volatile("" ::: "memory");
    if (!isr) return;
    f32x4 ar[2][2][2], ac[2][2][2];
    slab_sum<4>(rslabs + (size_t)(tile * 4) * 65536, s, ar);
    slab_sum<2>(cslabs + (size_t)(tile * 2) * 65536, s, ac);
    const int tid = threadIdx.x, wid = tid >> 6, lane = tid & 63, wr = wid >> 2, wc = wid & 3, fr = lane & 15, fq = lane >> 4;
    const int row0 = S.u0.pm * BM + wr * 64 + fr, col = S.u0.pn * BM + wc * 32 + 8 * fq;
#pragma unroll
    for (int c = 0; c < 2; ++c) {
        const int cmb = 2 * s + c, ai = cmb >> 2, m = cmb & 3;
        const size_t off = (size_t)(row0 + ai * HALF + m * 16) * 1024 + col;
#pragma unroll
        for (int bj = 0; bj < 2; ++bj) {
            f32x4 ga, gb, ha, hb; unpack8(*(const u32x4*)(sgr + off + bj * HALF), ga, gb); unpack8(*(const u32x4*)(sgc + off + bj * HALF), ha, hb);
            *(u32x4*)(mb + off + bj * HALF) = pack8(ar[c][bj][0] * ga + ac[c][bj][0] * ha, ar[c][bj][1] * gb + ac[c][bj][1] * hb);
        }
    }
}
template <class Epi> __device__ __forceinline__ void run_gemm_tail(LAS unsigned char* lds, Gemm g, Epi E, int k0, int klen, float* slabs, unsigned* cnt) {
    const int b = (int)blockIdx.x; if (b >= 128) return;
    const int tile = b >> 2, s = b & 3;
    StaticOrder T; T.init(g.M, g.N, (int)gridDim.x, 0); T.c = (int)gridDim.x + tile; OneUnit S; T.next(0, S.u0);
    Gemm gs = g; gs.ld = g.ld ? g.ld : g.K; gs.A = g.A + k0; gs.Bt = g.Bt + k0; gs.K = klen;
    EpiSlab<Epi::PERM> ES{slabs + (size_t)(tile * 4 + s) * 65536};
    gemm_phase<EpiSlab<Epi::PERM>, OneUnit>(lds, gs, S, ES, nullptr);
    tile_sync(cnt + tile * 16, 4u);
    f32x4 acc[2][2][4][2];
    const unsigned long long* sp = (const unsigned long long*)(slabs + (size_t)(tile * 4) * 65536) + threadIdx.x;
#pragma unroll
    for (int ai = 0; ai < 2; ++ai)
#pragma unroll
        for (int m = 0; m < 4; ++m) {
            if (((ai * 4 + m) >> 1) != s) continue;
#pragma unroll
            for (int bj = 0; bj < 2; ++bj)
#pragma unroll
                for (int n = 0; n < 2; ++n) { const int idx = (((ai * 4 + m) * 2 + bj) * 2 + n) * 2;
                    unsigned long long lo[4], hi[4];
#pragma unroll
                    for (int sl = 0; sl < 4; ++sl) { lo[sl] = __hip_atomic_load(sp + (size_t)sl * 32768 + (size_t)idx * 512, __ATOMIC_RELAXED, __HIP_MEMORY_SCOPE_AGENT);
                                                     hi[sl] = __hip_atomic_load(sp + (size_t)sl * 32768 + (size_t)(idx + 1) * 512, __ATOMIC_RELAXED, __HIP_MEMORY_SCOPE_AGENT); }
                    f32x4 v;
                    v[0] = (__uint_as_float((unsigned)lo[0]) + __uint_as_float((unsigned)lo[1])) + (__uint_as_float((unsigned)lo[2]) + __uint_as_float((unsigned)lo[3]));
                    v[1] = (__uint_as_float((unsigned)(lo[0] >> 32)) + __uint_as_float((unsigned)(lo[1] >> 32))) + (__uint_as_float((unsigned)(lo[2] >> 32)) + __uint_as_float((unsigned)(lo[3] >> 32)));
                    v[2] = (__uint_as_float((unsigned)hi[0]) + __uint_as_float((unsigned)hi[1])) + (__uint_as_float((unsigned)hi[2]) + __uint_as_float((unsigned)hi[3]));
                    v[3] = (__uint_as_float((unsigned)(hi[0] >> 32)) + __uint_as_float((unsigned)(hi[1] >> 32))) + (__uint_as_float((unsigned)(hi[2] >> 32)) + __uint_as_float((unsigned)(hi[3] >> 32)));
                    acc[ai][bj][m][n] = v; }
        }
    E.selmask = 3u << (2 * s);
    const int tid = threadIdx.x, wid = tid >> 6, lane = tid & 63;
    E(acc, S.u0, wid >> 2, wid & 3, lane & 15, lane >> 4);
}
constexpr int NPHASE = 11;
__global__ void __launch_bounds__(512, 2) mega(Params p) {
    extern __shared__ __attribute__((aligned(16))) unsigned char lds_raw[];
    LAS unsigned char* lds = (LAS unsigned char*)lds_raw;
    cg::grid_group grid = cg::this_grid();
    unsigned char* ws = p.ws;
    volatile LAS unsigned* xst = (volatile LAS unsigned*)(lds + 147456);
    if (threadIdx.x == 0) { xst[0] = 0u; xst[1] = 0u; }
    __syncthreads();
    const XcdBarrier xb = xcd_barrier_post((unsigned*)(ws + WS_BAR), xst);
#if MK_LAUNCHES == 1
#define RUN(k) true
#define SYNC() xcd_barrier(xb)
#define SYNC0() do { if (p.ph_lo > 1000) grid.sync(); xcd_barrier(xb); } while (0)
#else
#define RUN(k) (p.ph_lo == (k))
#define SYNC() do {} while (0)
#define SYNC0() do {} while (0)
#endif
    if (RUN(0)) phase_convert(p, lds, 0);
    SYNC0();
    if (RUN(1)) { Gemm g{(const bf16_t*)(ws + WS_XB), (const bf16_t*)(ws + WS_WIN), NTOK, 4096, 1024}; Epi1a E{(bf16_t*)(ws + WS_Q), (bf16_t*)(ws + WS_K), (bf16_t*)(ws + WS_V), (const float*)(ws + WS_ROPE)}; run_gemm<Epi1a>(lds, g, E);  if (blockIdx.x >= 128) phase_convert(p, lds, 1); }
    SYNC();
    if (RUN(2)) phase_retention(p, lds);
    SYNC();
    if (RUN(3)) { Gemm g{(const bf16_t*)(ws + WS_XB), (const bf16_t*)(ws + WS_WIN) + (size_t)4096 * 1024, NTOK, 7168, 1024}; Epi1b E{(bf16_t*)p.out, (bf16_t*)(ws + WS_Q), (bf16_t*)(ws + WS_K), (bf16_t*)(ws + WS_V), (bf16_t*)(ws + WS_V) + (size_t)NTOK * 1024, (const float*)(ws + WS_SSQ), p.out}; run_gemm<Epi1b>(lds, g, E); }
    SYNC();
    if (RUN(4)) phase_conv(p);
    SYNC();
    if (RUN(5)) {
        unsigned* tc = (unsigned*)(ws + WS_BAR) + XCD_BAR_WORDS;
        Gemm gr{(const bf16_t*)p.out, (const bf16_t*)(ws + WS_WR), NTOK, 1024, 2048, 2048}; EpiMerge<0> Er{(bf16_t*)(ws + WS_XB), (const bf16_t*)(ws + WS_V), 0xffu};
        Gemm gc{(const bf16_t*)(ws + WS_Q), (const bf16_t*)(ws + WS_WC), NTOK, 1024, 1024, 1024}; EpiMerge<1> Ec{(bf16_t*)(ws + WS_XB), (const bf16_t*)(ws + WS_V) + (size_t)NTOK * 1024, 0xffu};
        run_gemm_head<EpiMerge<0>>(lds, gr, Er);
        run_gemm_head<EpiMerge<1>>(lds, gc, Ec);
        merge_tails(lds, gr, gc, (bf16_t*)(ws + WS_XB), (const bf16_t*)(ws + WS_V), (const bf16_t*)(ws + WS_V) + (size_t)NTOK * 1024, (float*)(ws + WS_K), (float*)(ws + WS_CSLAB), tc, tc + 1024);
    }
    SYNC();
    if (RUN(6)) { Gemm g{(const bf16_t*)(ws + WS_XB), (const bf16_t*)(ws + WS_WO), NTOK, 1024, 1024, 1024}; EpiRes E{p.x_prompt, p.x_sample, p.out, 0xffu};
        run_gemm_head<EpiRes>(lds, g, E);
        run_gemm_tail<EpiRes>(lds, g, E, ((int)blockIdx.x & 3) * 256, 256, (float*)(ws + WS_K), (unsigned*)(ws + WS_BAR) + XCD_BAR_WORDS + 1536);
        if (blockIdx.x >= 128) phase_convert(p, lds, 3); }
    SYNC();
    if (RUN(7)) phase_ln(p.out, p.ln1_g, p.ln1_b, (bf16_t*)(ws + WS_XB), (float*)(ws + WS_ROPE));
    SYNC();
    if (RUN(8)) { Gemm g{(const bf16_t*)(ws + WS_XB), (const bf16_t*)(ws + WS_WUP), NTOK, 5632, 1024}; EpiUp E{(bf16_t*)(ws + WS_Q)}; run_gemm<EpiUp>(lds, g, E); }
    SYNC();
    if (RUN(9)) { Gemm g{(const bf16_t*)(ws + WS_Q), (const bf16_t*)(ws + WS_WD), NTOK, 1024, 2816, 2816}; EpiResLn E{p.out, p.ln1_g, p.ln1_b, (const float*)(ws + WS_ROPE), 0xffu};
        const int s4 = (int)blockIdx.x & 3;
        run_gemm_head<EpiResLn>(lds, g, E);
        run_gemm_tail<EpiResLn>(lds, g, E, s4 < 2 ? s4 * 768 : 1536 + (s4 - 2) * 640, s4 < 2 ? 768 : 640, (float*)(ws + WS_V + ((size_t)32 << 20)), (unsigned*)(ws + WS_BAR) + XCD_BAR_WORDS + 2048); }
    SYNC();
    if (RUN(10)) phase_ln(p.out, p.ln2_g, p.ln2_b, nullptr);
}

constexpr int LDS_BYTES = 147456 + 16;
extern "C" void kernel_launch(void* const* d_in, const int* in_sizes, int n_in, void* d_out, int out_size, void* d_ws, size_t ws_size, hipStream_t stream) {
    static int grid = 0;
    if (grid == 0) {
        if (n_in != 15 || ws_size < WS_END) { fprintf(stderr, "kernel_launch: need 15 inputs and %zu bytes of workspace; got %d, %zu\n", (size_t)WS_END, n_in, ws_size); grid = -1; return; }
        int dev = 0, cus = 0, per_cu = 0;
        hipGetDevice(&dev); hipDeviceGetAttribute(&cus, hipDeviceAttributeMultiprocessorCount, dev);
        if (hipFuncSetAttribute((const void*)mega, hipFuncAttributeMaxDynamicSharedMemorySize, LDS_BYTES) != hipSuccess) { fprintf(stderr, "kernel_launch: hipFuncSetAttribute failed\n"); grid = -1; return; }
        if (hipOccupancyMaxActiveBlocksPerMultiprocessor(&per_cu, (const void*)mega, 512, LDS_BYTES) != hipSuccess || per_cu < 1) { fprintf(stderr, "kernel_launch: occupancy query says %d\n", per_cu); per_cu = 1; }
        (void)hipGetLastError();
        grid = cus;
        if (grid != 256) { fprintf(stderr, "kernel_launch: built for a 256-CU device, found %d CUs\n", cus); grid = -1; return; }
        fprintf(stderr, "kernel_launch: grid %d (per_cu %d)\n", grid, per_cu);
    }
    if (grid < 0) return;
    if (hipMemsetAsync((char*)d_ws + WS_BAR, 0, (XCD_BAR_WORDS + TAIL_CNT_WORDS) * 4, stream) != hipSuccess) { fprintf(stderr, "kernel_launch: memset of barrier words failed\n"); return; }
    Params p{};
    p.x_prompt = (const float*)d_in[0]; p.x_sample = (const float*)d_in[1]; p.state_ret = (const float*)d_in[2]; p.cache_conv = (const float*)d_in[3];
    p.w_in = (const float*)d_in[4]; p.w_conv = (const float*)d_in[5]; p.w_ret_out = (const float*)d_in[6]; p.w_conv_out = (const float*)d_in[7]; p.w_o = (const float*)d_in[8];
    p.ln1_g = (const float*)d_in[9]; p.ln1_b = (const float*)d_in[10]; p.w_up = (const float*)d_in[11]; p.w_down = (const float*)d_in[12]; p.ln2_g = (const float*)d_in[13]; p.ln2_b = (const float*)d_in[14];
    p.out = (float*)d_out; p.ws = (unsigned char*)d_ws;
#if MK_LAUNCHES == 1
    p.ph_lo = 0; p.ph_hi = NPHASE;
    void* args[] = {&p};
    hipError_t e = hipLaunchCooperativeKernel((const void*)mega, dim3(grid), dim3(512), args, LDS_BYTES, stream);
    if (e != hipSuccess) fprintf(stderr, "cooperative launch failed: %s (grid %d)\n", hipGetErrorString(e), grid);
#else
    for (int ph = 0; ph < NPHASE; ++ph) { p.ph_lo = ph; p.ph_hi = ph + 1; hipLaunchKernelGGL(mega, dim3(grid), dim3(512), LDS_BYTES, stream, p); }
#endif
}
```
